# Optimizing an MI355X kernel written in HIP

```python
import math
import jax, jax.numpy as jnp
from jax import lax
import numpy as np

D_MODEL = 1024
BATCH = 4
SEQ = 4096
DEPTH = 1

CHUNK = 64
Q_BLOCK = 128
D_MIX = D_MODEL
D_ATTN = D_MIX // 2
D_CONV = D_MIX - D_ATTN
N_HEADS = 4
HEAD_DIM = D_ATTN // N_HEADS
SUB_DIM = HEAD_DIM // 2
ROPE_DIM = SUB_DIM // 4
ROPE_THETA = 500000.0
CONV_WIDTH = 31
N_EXPERTS = 64
TOP_K = 8
N_GROUPS = 8
TOPK_GROUPS = 4
D_EXPERT = 256
D_SHARED = 256
ROUTED_SCALE = 2.5
EXPERT_BLOCK = 128
LN_EPS = 1e-5
ALPHA = (2.0 * DEPTH) ** 0.25
BETA = (8.0 * DEPTH) ** -0.25
D_IN = 3 * D_ATTN + 2 * D_CONV

kernel_name = "hybrid_diffattn_conformerconv_moe_deepnorm"


def layer_norm(x, g, b):
    xf = x.astype(jnp.float32)
    mu = jnp.mean(xf, axis=-1, keepdims=True)
    var = jnp.mean(jnp.square(xf - mu), axis=-1, keepdims=True)
    y = (xf - mu) * lax.rsqrt(var + LN_EPS) * g.astype(jnp.float32) + b.astype(jnp.float32)
    return y.astype(x.dtype)


def rms_norm(x, g):
    xf = x.astype(jnp.float32)
    y = xf * lax.rsqrt(jnp.mean(jnp.square(xf), axis=-1, keepdims=True) + LN_EPS)
    return (y * g.astype(jnp.float32)).astype(x.dtype)


def partial_rope(t, positions):
    inv_freq = ROPE_THETA ** (-jnp.arange(0, ROPE_DIM, 2, dtype=jnp.float32) / ROPE_DIM)
    ang = positions.astype(jnp.float32)[:, :, None] * inv_freq
    cos = jnp.cos(ang)[:, :, None, None, :]
    sin = jnp.sin(ang)[:, :, None, None, :]
    r1 = t[..., : ROPE_DIM // 2].astype(jnp.float32)
    r2 = t[..., ROPE_DIM // 2 : ROPE_DIM].astype(jnp.float32)
    rot = jnp.concatenate([r1 * cos - r2 * sin, r2 * cos + r1 * sin], axis=-1).astype(t.dtype)
    return jnp.concatenate([rot, t[..., ROPE_DIM:]], axis=-1)


def diff_attention(q, k, v, lam, sub_g, lambda_init):
    B, S = q.shape[0], q.shape[1]
    nb = S // Q_BLOCK
    kT = k.transpose(0, 2, 3, 1, 4)
    vT = v.transpose(0, 2, 1, 3)
    qb = (q * (SUB_DIM ** -0.5)).reshape(B, nb, Q_BLOCK, N_HEADS, 2, SUB_DIM)
    qb = qb.transpose(1, 0, 3, 4, 2, 5)
    key_chunk = jnp.arange(S) // CHUNK

    def block(args):
        q_blk, i = args
        s = jnp.einsum('bhcqd,bhckd->bhcqk', q_blk, kT).astype(jnp.float32)
        q_chunk = (i * Q_BLOCK + jnp.arange(Q_BLOCK)) // CHUNK
        mask = key_chunk[None, :] <= q_chunk[:, None]
        p = jax.nn.softmax(jnp.where(mask, s, -jnp.inf), axis=-1)
        a = p[:, :, 0] - lam * p[:, :, 1]
        return jnp.einsum('bhqk,bhkv->bhqv', a.astype(vT.dtype), vT)

    o = lax.map(block, (qb, jnp.arange(nb)))
    o = rms_norm(o, sub_g) * (1.0 - lambda_init)
    return o.transpose(1, 0, 3, 2, 4).reshape(B, S, D_ATTN)


def conformer_conv(u, conv_w, conv_b, ln_g, ln_b):
    a, gate = jnp.split(u, 2, axis=-1)
    h = a * jax.nn.sigmoid(gate)
    h = lax.conv_general_dilated(h, conv_w[:, None, :], window_strides=(1,),
                                 padding=[(CONV_WIDTH - 1, 0)],
                                 dimension_numbers=('NWC', 'WIO', 'NWC'),
                                 feature_group_count=D_CONV) + conv_b
    h = layer_norm(h, ln_g, ln_b)
    return jax.nn.silu(h)


def moe_ffn(x, w_router, router_bias, w_gate, w_up, w_down, ws_gate, ws_up, ws_down):
    B, S, D = x.shape
    N = B * S
    xf = x.reshape(N, D)
    scores = jax.nn.sigmoid((xf @ w_router).astype(jnp.float32))
    biased = scores + router_bias.astype(jnp.float32)
    grp = biased.reshape(N, N_GROUPS, N_EXPERTS // N_GROUPS)
    grp_score = lax.top_k(grp, 2)[0].sum(-1)
    _, top_grp = lax.top_k(grp_score, TOPK_GROUPS)
    grp_mask = jax.nn.one_hot(top_grp, N_GROUPS, dtype=jnp.float32).sum(1) > 0
    exp_mask = jnp.repeat(grp_mask, N_EXPERTS // N_GROUPS, axis=1)
    _, top_idx = lax.top_k(jnp.where(exp_mask, biased, -jnp.inf), TOP_K)
    top_s = jnp.take_along_axis(scores, top_idx, axis=1)
    gates = (top_s / jnp.sum(top_s, axis=-1, keepdims=True)) * ROUTED_SCALE

    NK = N * TOP_K
    flat_e = top_idx.reshape(NK)
    flat_tok = jnp.repeat(jnp.arange(N, dtype=jnp.int32), TOP_K)
    flat_gate = gates.reshape(NK)
    order = jnp.argsort(flat_e)
    se, stok, sgate = flat_e[order], flat_tok[order], flat_gate[order]
    counts = jnp.bincount(flat_e, length=N_EXPERTS)
    starts = jnp.cumsum(counts) - counts
    padded = (counts + EXPERT_BLOCK - 1) // EXPERT_BLOCK * EXPERT_BLOCK
    pad_end = jnp.cumsum(padded)
    pad_start = pad_end - padded
    dest = pad_start[se] + (jnp.arange(NK) - starts[se])
    n_blocks = (NK + N_EXPERTS * (EXPERT_BLOCK - 1) + EXPERT_BLOCK - 1) // EXPERT_BLOCK
    P = n_blocks * EXPERT_BLOCK
    row_tok = jnp.zeros((P,), jnp.int32).at[dest].set(stok)
    row_gate = jnp.zeros((P,), jnp.float32).at[dest].set(sgate)
    blk_exp = jnp.minimum(jnp.searchsorted(pad_end, jnp.arange(n_blocks) * EXPERT_BLOCK, side='right'),
                          N_EXPERTS - 1)

    def expert_block(args):
        tok, g, e = args
        h = xf[tok]
        a = jax.nn.silu(h @ w_gate[e]) * (h @ w_up[e])
        return (a @ w_down[e]) * g[:, None].astype(xf.dtype)

    y = lax.map(expert_block, (row_tok.reshape(n_blocks, EXPERT_BLOCK),
                               row_gate.reshape(n_blocks, EXPERT_BLOCK), blk_exp))
    routed = jnp.zeros((N, D), xf.dtype).at[row_tok].add(y.reshape(P, D))
    shared = (jax.nn.silu(xf @ ws_gate) * (xf @ ws_up)) @ ws_down
    return (routed + shared).reshape(B, S, D)


def setup_inputs(seed: int = 0) -> dict:
    key = jax.random.key(seed)
    ks = jax.random.split(key, 26)
    f32 = jnp.float32
    nrm = lambda k, shape, s: jax.random.normal(k, shape, f32) * s
    L = DEPTH
    offset = jax.random.randint(ks[1], (BATCH, 1), 0, 65536, dtype=jnp.int32)
    return {
        "x": jax.random.normal(ks[0], (BATCH, SEQ, D_MODEL), f32),
        "positions": offset + jnp.arange(SEQ, dtype=jnp.int32)[None, :],
        "w_in": nrm(ks[2], (L, D_MODEL, D_IN), D_MODEL ** -0.5),
        "lambda_q1": nrm(ks[3], (L, SUB_DIM), 0.1),
        "lambda_k1": nrm(ks[4], (L, SUB_DIM), 0.1),
        "lambda_q2": nrm(ks[5], (L, SUB_DIM), 0.1),
        "lambda_k2": nrm(ks[6], (L, SUB_DIM), 0.1),
        "subln_g": 1.0 + nrm(ks[7], (L, HEAD_DIM), 0.02),
        "conv_w": nrm(ks[8], (L, CONV_WIDTH, D_CONV), CONV_WIDTH ** -0.5),
        "conv_b": nrm(ks[9], (L, D_CONV), 0.02),
        "conv_ln_g": 1.0 + nrm(ks[10], (L, D_CONV), 0.02),
        "conv_ln_b": nrm(ks[11], (L, D_CONV), 0.02),
        "w_out": nrm(ks[12], (L, D_MIX, D_MODEL), BETA * D_MIX ** -0.5),
        "ln1_g": 1.0 + nrm(ks[13], (L, D_MODEL), 0.02),
        "ln1_b": nrm(ks[14], (L, D_MODEL), 0.02),
        "w_router": nrm(ks[15], (L, D_MODEL, N_EXPERTS), D_MODEL ** -0.5),
        "router_bias": nrm(ks[16], (L, N_EXPERTS), 0.01),
        "w_exp_gate": nrm(ks[17], (L, N_EXPERTS, D_MODEL, D_EXPERT), D_MODEL ** -0.5),
        "w_exp_up": nrm(ks[18], (L, N_EXPERTS, D_MODEL, D_EXPERT), D_MODEL ** -0.5),
        "w_exp_down": nrm(ks[19], (L, N_EXPERTS, D_EXPERT, D_MODEL), BETA * D_EXPERT ** -0.5),
        "w_sh_gate": nrm(ks[20], (L, D_MODEL, D_SHARED), D_MODEL ** -0.5),
        "w_sh_up": nrm(ks[21], (L, D_MODEL, D_SHARED), D_MODEL ** -0.5),
        "w_sh_down": nrm(ks[22], (L, D_SHARED, D_MODEL), BETA * D_SHARED ** -0.5),
        "ln2_g": 1.0 + nrm(ks[23], (L, D_MODEL), 0.02),
        "ln2_b": nrm(ks[24], (L, D_MODEL), 0.02),
    }


def reference(x, positions, w_in, lambda_q1, lambda_k1, lambda_q2, lambda_k2, subln_g,
              conv_w, conv_b, conv_ln_g, conv_ln_b, w_out, ln1_g, ln1_b,
              w_router, router_bias, w_exp_gate, w_exp_up, w_exp_down,
              w_sh_gate, w_sh_up, w_sh_down, ln2_g, ln2_b):
    B, S = x.shape[0], x.shape[1]
    for l in range(DEPTH):
        lambda_init = 0.8 - 0.6 * math.exp(-0.3 * l)
        proj = x @ w_in[l]
        q = proj[..., :D_ATTN].reshape(B, S, N_HEADS, 2, SUB_DIM)
        k = proj[..., D_ATTN:2 * D_ATTN].reshape(B, S, N_HEADS, 2, SUB_DIM)
        v = proj[..., 2 * D_ATTN:3 * D_ATTN].reshape(B, S, N_HEADS, HEAD_DIM)
        u = proj[..., 3 * D_ATTN:]
        q = partial_rope(q, positions)
        k = partial_rope(k, positions)
        lam = (jnp.exp(jnp.sum(lambda_q1[l].astype(jnp.float32) * lambda_k1[l].astype(jnp.float32)))
               - jnp.exp(jnp.sum(lambda_q2[l].astype(jnp.float32) * lambda_k2[l].astype(jnp.float32)))
               + lambda_init)
        attn_out = diff_attention(q, k, v, lam, subln_g[l], lambda_init)
        conv_out = conformer_conv(u, conv_w[l], conv_b[l], conv_ln_g[l], conv_ln_b[l])
        mix = jnp.concatenate([attn_out, conv_out], axis=-1) @ w_out[l]
        x = layer_norm(ALPHA * x + mix, ln1_g[l], ln1_b[l])
        ffn = moe_ffn(x, w_router[l], router_bias[l], w_exp_gate[l], w_exp_up[l], w_exp_down[l],
                      w_sh_gate[l], w_sh_up[l], w_sh_down[l])
        x = layer_norm(ALPHA * x + ffn, ln2_g[l], ln2_b[l])
    return x
```

```cpp
#include <hip/hip_runtime.h>
#include <hip/hip_cooperative_groups.h>
#include <cstdio>
#include <cstdint>
#include <cstring>
namespace cg = cooperative_groups;
#ifndef MK_DUP
#define MK_DUP 0
#endif

#define LAS __attribute__((address_space(3)))
#define GAS __attribute__((address_space(1)))
typedef unsigned short bf16_t;
typedef short bf16x8 __attribute__((ext_vector_type(8)));
typedef float f32x4 __attribute__((ext_vector_type(4)));
typedef float f32x2 __attribute__((ext_vector_type(2)));
typedef float f32x16 __attribute__((ext_vector_type(16)));
typedef unsigned u32x4 __attribute__((ext_vector_type(4)));
typedef unsigned u32x2 __attribute__((ext_vector_type(2)));

constexpr int D_MODEL = 1024, BATCH = 4, SEQ = 4096, M_TOK = BATCH * SEQ;
constexpr int D_IN = 2560, N_HEADS = 4, HEAD_DIM = 128, SUB_DIM = 64, D_CONV = 512;
constexpr int CONV_W = 31, N_EXP = 64, TOP_K = 8, D_EXP = 256;
constexpr float LN_EPS = 1e-5f, ALPHA = 1.189207115002721f, ROUTED_SCALE = 2.5f, LAMBDA_INIT = 0.2f;
constexpr float QSCALE = 0.125f * 1.4426950408889634f;
constexpr int NWAVES = 8, NTHREADS = 512;

constexpr size_t MiB = 1u << 20;
constexpr size_t WS_CTL = 0, CTL_ZERO_BYTES = 64 * 1024;
constexpr size_t WS_ROPE = 1 * MiB;
constexpr size_t WS_SMALL = 2 * MiB;
constexpr size_t WS_WIN = 3 * MiB;
constexpr size_t WS_WOUT = 8 * MiB;
constexpr size_t WS_WR = 10 * MiB;
constexpr size_t WS_WSGU = 11 * MiB;
constexpr size_t WS_WSD = 12 * MiB;
constexpr size_t WS_WD = 13 * MiB;
constexpr size_t WS_WGU = 45 * MiB;
constexpr size_t WS_XB = 109 * MiB;
constexpr size_t WS_QIMG = 141 * MiB, WS_KIMG = 157 * MiB, WS_VIMG = 173 * MiB, WS_HC = 189 * MiB;
constexpr size_t WS_MIXIN = 205 * MiB;
constexpr size_t WS_Y1 = 109 * MiB;
constexpr size_t WS_YST = 141 * MiB;
constexpr size_t WS_YH = 45 * MiB;
constexpr size_t WS_H = 173 * MiB;
constexpr size_t WS_ROWPAIR = 246 * MiB;
constexpr size_t WS_GATE = 250 * MiB;
constexpr size_t WS_PAIRPOS = 250 * MiB + 512 * 1024;
constexpr size_t WS_SH = 251 * MiB;
constexpr size_t WS_END = 267 * MiB;
constexpr int CW_BAR = 1024;
constexpr int CW_ECNT = 8192;
constexpr int CW_TMO = 0;

typedef __bf16 bf16x2_t __attribute__((ext_vector_type(2)));
__device__ __forceinline__ unsigned cvt_pk_bf16(float lo, float hi) { f32x2 v = {lo, hi}; bf16x2_t b = __builtin_convertvector(v, bf16x2_t); return __builtin_bit_cast(unsigned, b); }
__device__ __forceinline__ float bf2f(unsigned short b) { return __uint_as_float((unsigned)b << 16); }
__device__ __forceinline__ float bflo(unsigned w) { return __uint_as_float(w << 16); }
__device__ __forceinline__ float bfhi(unsigned w) { return __uint_as_float(w & 0xffff0000u); }
__device__ __forceinline__ float wave_sum(float v) {
#pragma unroll
    for (int o = 1; o < 64; o <<= 1) v += __shfl_xor(v, o);
    return v;
}
__device__ __forceinline__ int lane_id() { int l; asm volatile("v_mbcnt_lo_u32_b32 %0, -1, 0\n\tv_mbcnt_hi_u32_b32 %0, -1, %0" : "=v"(l)); return l; }
__device__ __forceinline__ void store16_wt(void* p, u32x4 v) { asm volatile("global_store_dwordx4 %0, %1, off sc1\n\ts_nop 1" :: "v"(p), "v"(v) : "memory"); }
__device__ __forceinline__ float sigmoidf_(float x) { return __builtin_amdgcn_rcpf(1.f + __expf(-x)); }

#define XB_TMO      128
#define XB_XCNT(j)  (256  + 64 * (j))
#define XB_XSUB(j)  (1280 + 64 * (j))
#define XB_XGEN(j)  (2304 + 64 * (j))
#define XB_TOP      3328
#define XB_TOPGEN   3392
#define XCD_BAR_WORDS 3456
#define XB_SPIN_CAP (1u << 18)
__device__ __forceinline__ unsigned xb_ld(unsigned* p)              { return __hip_atomic_load(p, __ATOMIC_RELAXED, __HIP_MEMORY_SCOPE_AGENT); }
__device__ __forceinline__ unsigned xb_add(unsigned* p, unsigned v) { return __hip_atomic_fetch_add(p, v, __ATOMIC_RELAXED, __HIP_MEMORY_SCOPE_AGENT); }
__device__ __forceinline__ unsigned xb_xcc_id() { return (unsigned)__builtin_amdgcn_s_getreg((3 << 11) | 20) & 0xFu; }
#define XB_SPIN(cond, bar) do { unsigned _sp = 0; while (cond) { __builtin_amdgcn_s_sleep(1); \
    if ((++_sp & 255u) == 0u) { if (xb_ld(&(bar)[XB_TMO])) break; if (_sp > XB_SPIN_CAP) { atomicAdd(&(bar)[XB_TMO], 1u); break; } } } } while (0)
struct XcdBarrier { unsigned* bar; unsigned x; volatile LAS unsigned* st; int wave; };
__device__ __forceinline__ XcdBarrier xcd_barrier_post(unsigned* bar, volatile LAS unsigned* st, int wave) {
    XcdBarrier b; b.bar = bar; b.x = xb_xcc_id(); b.st = st; b.wave = wave;
    if (wave == 0 && lane_id() == 0) (void)xb_add(&bar[XB_XCNT(b.x)], 1u);
    return b;
}
__device__ __forceinline__ void xcd_barrier_complete(unsigned* bar, unsigned x, unsigned& nloc, unsigned& nx) {
    const unsigned G = gridDim.x * gridDim.y * gridDim.z;
    unsigned sum, cnt, mine, sp = 0u;
    for (;;) {
        sum = 0u; cnt = 0u; mine = 0u;
#pragma unroll
        for (unsigned j = 0; j < 16; ++j) { const unsigned c = xb_ld(&bar[XB_XCNT(j)]); sum += c; cnt += (c > 0u) ? 1u : 0u; mine = (j == x) ? c : mine; }
        if (sum == G) break;
        __builtin_amdgcn_s_sleep(1);
        if ((++sp & 255u) == 0u) { if (xb_ld(&bar[XB_TMO])) break; if (sp > XB_SPIN_CAP) { atomicAdd(&bar[XB_TMO], 1u); break; } }
    }
    nloc = mine > 0u ? mine : 1u; nx = cnt > 0u ? cnt : 1u;
}
__device__ __forceinline__ void xcd_barrier(const XcdBarrier& b) {
    asm volatile("s_waitcnt vmcnt(0)" ::: "memory");
    __syncthreads();
    if (b.wave == 0 && lane_id() == 0) {
        unsigned* bar = b.bar;
        __builtin_amdgcn_s_waitcnt(0);
        unsigned nloc = b.st[0], nx = b.st[1];
        if (nloc == 0u) { xcd_barrier_complete(bar, b.x, nloc, nx); b.st[0] = nloc; b.st[1] = nx; }
        const unsigned old = xb_add(&bar[XB_XSUB(b.x)], 1u);
        const unsigned gen = old / nloc;
        if (old + 1u == (gen + 1u) * nloc) {
            __builtin_amdgcn_fence(__ATOMIC_RELEASE, "agent");
            asm volatile("s_waitcnt vmcnt(0)" ::: "memory");
            const unsigned og = xb_add(&bar[XB_TOP], 1u);
            const unsigned tg = og / nx;
            if (og + 1u == (tg + 1u) * nx) xb_add(&bar[XB_TOPGEN], 1u);
            else XB_SPIN(xb_ld(&bar[XB_TOPGEN]) == tg, bar);
            __builtin_amdgcn_fence(__ATOMIC_ACQUIRE, "agent");
            xb_add(&bar[XB_XGEN(b.x)], 1u);
            asm volatile("s_waitcnt vmcnt(0)" ::: "memory");
        } else {
            XB_SPIN(xb_ld(&bar[XB_XGEN(b.x)]) == gen, bar);
            __builtin_amdgcn_fence(__ATOMIC_ACQUIRE, "agent");
            asm volatile("s_waitcnt vmcnt(0)" ::: "memory");
        }
    }
    __syncthreads();
}

namespace pg8 {
constexpr int BM = 256, BK = 64, HALF = 128, HTB = HALF * BK * 2, STAGE_BYTES = 8 * HTB, NXCD = 8, WGM = 1;
__host__ __device__ __forceinline__ int lds_byte(int r, int c) { const int st = (r >> 4) * 2 + (c >> 5), rr = r & 15, cc = c & 31, ob = rr * 64 + cc * 2; return st * 1024 + (ob ^ (((ob >> 9) & 1) << 5)); }
__host__ __device__ __forceinline__ void stage_rc(int b, int& R, int& C) { const int st = b / 1024, sb = b % 1024, swz = sb ^ (((sb >> 9) & 1) << 5); R = (st >> 1) * 16 + swz / 64; C = (st & 1) * 32 + (swz % 64) / 2; }
__host__ __device__ __forceinline__ int perm32(int rho) { const int n = rho >> 4, i = rho & 15; return 8 * (i >> 2) + 4 * n + (i & 3); }

struct Unit { int pm, pn, e, cnt, arow0; const char* Bp; };

struct StaticOrder {
    int nM, nN, nwg, G, c; const char* Bt; int Kb  ; int skip_lo, skip_n;
    __device__ void init(int M, int N, int K, const void* Bt_, int G_, int c_) { nM = M / BM; nN = N / BM; nwg = nM * nN; G = G_; c = c_; Bt = (const char*)Bt_; Kb = K * 2; skip_lo = 1 << 30; skip_n = 0; }
    __device__ bool next(int i, Unit& u) const {
        const long L = (long)i * G + c; if (L >= nwg) return false;
        int wgid = (int)L; { const int q = nwg / NXCD, r = nwg % NXCD, xcd = wgid % NXCD, off = wgid / NXCD; wgid = (xcd < r ? xcd * (q + 1) : r * (q + 1) + (xcd - r) * q) + off; }
        const int nig = WGM * nN, gid = wgid / nig, fm = gid * WGM, gsz = (nM - fm) < WGM ? (nM - fm) : WGM;
        u.pm = fm + ((wgid % nig) % gsz); u.pn = (wgid % nig) / gsz; if (u.pn >= skip_lo) u.pn += skip_n; u.e = 0; u.cnt = 256; u.arow0 = u.pm * BM;
        u.Bp = Bt + (size_t)u.pn * BM * Kb; return true;
    }
    __device__ __forceinline__ int arow(const Unit& u, int r) const { return u.arow0 + r; }
};

template <class Epi, class Sched, bool ALIGN_EPI, bool SWAP>
__device__ __forceinline__ void gemm_phase(LAS unsigned char* lds, const int wid, const void* Abase, const int lda_bytes, const int K, const Sched& S, const Epi& E) {
    const int lane = lane_id(), tid = wid * 64 + lane, wr = wid >> 2, wc = wid & 3, fr = lane & 15, fq = lane >> 4;
    const int nt = K / BK;
    int sR[2], sC[2]; unsigned voffB[2];
#pragma unroll
    for (int i = 0; i < 2; ++i) { int R, C; stage_rc(tid * 16 + i * 8192, R, C); const int Rb = Epi::PERM ? ((R & ~31) + perm32(R & 31)) : R;
        sR[i] = R; sC[i] = C * 2; voffB[i] = (unsigned)(Rb * K + C) * 2u; }
    const size_t kstep = (size_t)(BK * 2);
    const size_t hstepB = (size_t)HALF * K * 2;
    const unsigned ldsw = (unsigned)wid * 1024u;
    const int aoff = lds_byte(wr * 64 + fr, fq * 8), boff = lds_byte(wc * 32 + fr, fq * 8);
    const char* Ab = (const char*)Abase;
#define PG8_SA(b, h) (((b) * 2 + (h)) * HTB)
#define PG8_SB(b, h) ((4 + (b) * 2 + (h)) * HTB)
#define PG8_STAGE(bufoff, gbase, voff) do { _Pragma("unroll") for (int _i = 0; _i < 2; ++_i) \
        __builtin_amdgcn_global_load_lds((const unsigned*)((const char*)(gbase) + (voff)[_i]), (LAS unsigned*)(lds + (bufoff) + ldsw + _i * 8192), 16, 0, 0); } while (0)
#define PG8_LDA(dst, b, h) do { _Pragma("unroll") for (int m = 0; m < 4; ++m) _Pragma("unroll") for (int k = 0; k < 2; ++k) dst[m][k] = *(const LAS bf16x8*)(lds + PG8_SA(b, h) + aoff + m * 2048 + k * 1024); } while (0)
#define PG8_LDB(dst, b, h) do { _Pragma("unroll") for (int n = 0; n < 2; ++n) _Pragma("unroll") for (int k = 0; k < 2; ++k) dst[n][k] = *(const LAS bf16x8*)(lds + PG8_SB(b, h) + boff + n * 2048 + k * 1024); } while (0)
#define PG8_MMA(ai, bj, At, Bt) do { __builtin_amdgcn_s_setprio(1); \
        if constexpr (SWAP) { _Pragma("unroll") for (int m = 0; m < 4; ++m) _Pragma("unroll") for (int n = 0; n < 2; ++n) _Pragma("unroll") for (int k = 0; k < 2; ++k) \
            acc[ai][bj][m][n] = __builtin_amdgcn_mfma_f32_16x16x32_bf16(At[m][k], Bt[n][k], acc[ai][bj][m][n], 0, 0, 0); } \
        else { _Pragma("unroll") for (int m = 0; m < 4; ++m) _Pragma("unroll") for (int n = 0; n < 2; ++n) _Pragma("unroll") for (int k = 0; k < 2; ++k) \
            acc[ai][bj][m][n] = __builtin_amdgcn_mfma_f32_16x16x32_bf16(Bt[n][k], At[m][k], acc[ai][bj][m][n], 0, 0, 0); } \
        __builtin_amdgcn_s_setprio(0); } while (0)
#define PG8_WAIT_V(n) asm volatile("s_waitcnt vmcnt(" #n ")" ::: "memory")
#define PG8_WAIT_L(n) asm volatile("s_waitcnt lgkmcnt(" #n ")" ::: "memory")
#define PG8_BAR __builtin_amdgcn_s_barrier()
#define PG8_SCHED __builtin_amdgcn_sched_barrier(0)
#define PG8_AOFF(dst, u) do { _Pragma("unroll") for (int _h = 0; _h < 2; ++_h) _Pragma("unroll") for (int _i = 0; _i < 2; ++_i) \
        dst[_h][_i] = (unsigned)S.arow(u, _h * HALF + sR[_i]) * (unsigned)lda_bytes + (unsigned)sC[_i]; } while (0)
    Unit cur, nxt; int ui = 0;
    if (!S.next(0, cur)) return;
    f32x4 acc[2][2][4][2];
#pragma unroll
    for (int a = 0; a < 2; ++a)
#pragma unroll
        for (int b = 0; b < 2; ++b)
#pragma unroll
            for (int m = 0; m < 4; ++m)
#pragma unroll
                for (int n = 0; n < 2; ++n) acc[a][b][m][n] = (f32x4){0.f, 0.f, 0.f, 0.f};
    bf16x8 At[4][2], B0[2][2], B1[2][2];
    unsigned aoC[2][2];
    PG8_AOFF(aoC, cur);
    const char* cB = cur.Bp;
    PG8_STAGE(PG8_SB(0, 0), cB, voffB); PG8_STAGE(PG8_SB(0, 1), cB + hstepB, voffB); PG8_STAGE(PG8_SA(0, 0), Ab, aoC[0]); PG8_STAGE(PG8_SA(0, 1), Ab, aoC[1]);
    if (wr == 1) PG8_BAR;
    PG8_WAIT_V(2); PG8_BAR;
    PG8_STAGE(PG8_SB(1, 0), cB + kstep, voffB); PG8_STAGE(PG8_SA(1, 0), Ab + kstep, aoC[0]); PG8_STAGE(PG8_SB(1, 1), cB + hstepB + kstep, voffB);
    PG8_WAIT_V(6); PG8_BAR;
    for (;;) {
        const bool has_next = S.next(ui + 1, nxt);
        unsigned aoN[2][2];
        if (has_next) { PG8_AOFF(aoN, nxt); } else {
#pragma unroll
            for (int h = 0; h < 2; ++h)
#pragma unroll
                for (int i = 0; i < 2; ++i) aoN[h][i] = aoC[h][i]; }
        const char* nB = has_next ? nxt.Bp : cB;
_Pragma("unroll 1")
        for (int t = 0; t < nt; t += 2) {
            const bool last = (t == nt - 2);
            const char* a1 = Ab + (size_t)(t + 1) * kstep;
            const char* a2 = last ? Ab : Ab + (size_t)(t + 2) * kstep; const char* b2 = last ? nB : cB + (size_t)(t + 2) * kstep;
            const char* a3 = a2 + kstep; const char* b3 = b2 + kstep;
            PG8_LDB(B0, 0, 0); PG8_LDB(B1, 0, 1); PG8_SCHED; PG8_LDA(At, 0, 0); PG8_STAGE(PG8_SA(1, 1), a1, aoC[1]);
            { const unsigned msk = last ? 0xffffffffu : 0u;
              _Pragma("unroll") for (int h = 0; h < 2; ++h)
                _Pragma("unroll") for (int i = 0; i < 2; ++i) aoC[h][i] = (aoN[h][i] & msk) | (aoC[h][i] & ~msk); }
            PG8_WAIT_V(8); PG8_WAIT_L(0); PG8_BAR; PG8_MMA(0, 0, At, B0); PG8_MMA(0, 1, At, B1); PG8_BAR; PG8_SCHED;
            PG8_LDA(At, 0, 1); PG8_STAGE(PG8_SB(0, 0), b2, voffB); PG8_STAGE(PG8_SB(0, 1), b2 + hstepB, voffB); PG8_STAGE(PG8_SA(0, 0), a2, aoC[0]);
            PG8_WAIT_V(8); PG8_WAIT_L(0); PG8_BAR; PG8_MMA(1, 0, At, B0); PG8_MMA(1, 1, At, B1); PG8_BAR; PG8_SCHED;
            PG8_LDB(B0, 1, 0); PG8_LDB(B1, 1, 1); PG8_SCHED; PG8_LDA(At, 1, 0); PG8_STAGE(PG8_SA(0, 1), a2, aoC[1]);
            PG8_WAIT_V(8); PG8_WAIT_L(0); PG8_BAR; PG8_MMA(0, 0, At, B0); PG8_MMA(0, 1, At, B1); PG8_BAR; PG8_SCHED;
            PG8_LDA(At, 1, 1); PG8_STAGE(PG8_SB(1, 0), b3, voffB); PG8_STAGE(PG8_SB(1, 1), b3 + hstepB, voffB); PG8_STAGE(PG8_SA(1, 0), a3, aoC[0]);
            PG8_WAIT_V(8); PG8_WAIT_L(0); PG8_BAR; PG8_MMA(1, 0, At, B0); PG8_MMA(1, 1, At, B1); PG8_BAR; PG8_SCHED;
        }
        if constexpr (ALIGN_EPI) { if (wr == 0) PG8_BAR; }
        E(acc, cur, wr, wc, fr, fq);
        if (!has_next) break;
#pragma unroll
        for (int a = 0; a < 2; ++a)
#pragma unroll
            for (int b = 0; b < 2; ++b)
#pragma unroll
                for (int m = 0; m < 4; ++m)
#pragma unroll
                    for (int n = 0; n < 2; ++n) acc[a][b][m][n] = (f32x4){0.f, 0.f, 0.f, 0.f};
        cur = nxt; cB = nB; ++ui;
        if constexpr (ALIGN_EPI) { if (wr == 1) PG8_BAR; }
    }
    PG8_WAIT_V(0);
    if constexpr (!ALIGN_EPI) { if (wr == 0) PG8_BAR; }
    PG8_BAR;
#undef PG8_SA
#undef PG8_SB
#undef PG8_STAGE
#undef PG8_LDA
#undef PG8_LDB
#undef PG8_MMA
#undef PG8_WAIT_V
#undef PG8_WAIT_L
#undef PG8_BAR
#undef PG8_SCHED
#undef PG8_AOFF
}
}

constexpr int RING_BYTES = 131072, MISC_OFF = RING_BYTES + 320, LDS_BYTES = 147456;
struct Frame {
    LAS unsigned char* lds; volatile LAS unsigned* MISC; unsigned* ctl;
    int wave, vcu, G;
    float* out; unsigned char* ws;
};
__device__ __forceinline__ const float* in_ptr(const Frame& F, int i) {
    const unsigned lo = __builtin_amdgcn_readfirstlane(F.MISC[32 + 2 * i]), hi = __builtin_amdgcn_readfirstlane(F.MISC[33 + 2 * i]);
    return (const float*)(((unsigned long long)hi << 32) | (unsigned long long)lo);
}

struct P0Item { const float* src; bf16_t* dst; int N, K; float scale; };
__device__ __forceinline__ int map_win(int n0) { if (n0 < 1536) return n0; const int j = n0 - 1536, gate = j >> 9, ch = j & 511; return 1536 + (ch >> 7) * 256 + gate * 128 + (ch & 127); }
__device__ __forceinline__ int map_gu(int n0, int up) { return (n0 >> 7) * 256 + up * 128 + (n0 & 127); }
__device__ __forceinline__ P0Item p0_decode(const Frame& F, int it) {
    constexpr int I_WIN = 16 * 80, I_WOUT = 16 * 32, I_WR = 16 * 2, I_E = 128;
    unsigned char* ws = F.ws; P0Item r; r.scale = 1.f; int q = it;
    if (q < I_WIN) { const int kb = q / 80, nb = q % 80; r.N = 2560; r.K = 1024; r.src = in_ptr(F, 2) + (size_t)kb * 64 * 2560 + nb * 32; r.dst = (bf16_t*)(ws + WS_WIN) + (size_t)map_win(nb * 32) * 1024 + kb * 64; return r; } q -= I_WIN;
    if (q < I_WOUT) { const int kb = q / 32, nb = q % 32; r.N = 1024; r.K = 1024; r.src = in_ptr(F, 12) + (size_t)kb * 64 * 1024 + nb * 32; r.dst = (bf16_t*)(ws + WS_WOUT) + (size_t)(nb * 32) * 1024 + kb * 64; return r; } q -= I_WOUT;
    if (q < I_WR) { const int kb = q / 2, nb = q % 2; r.N = 64; r.K = 1024; r.src = in_ptr(F, 15) + (size_t)kb * 64 * 64 + nb * 32; r.dst = (bf16_t*)(ws + WS_WR) + (size_t)(nb * 32) * 1024 + kb * 64; return r; } q -= I_WR;
    const int e = q / (3 * I_E) - 1, w = (q / I_E) % 3, qq = q % I_E;
    if (w < 2) { const int kb = qq / 8, nb = qq % 8; r.N = 256; r.K = 1024;
        const float* base = e < 0 ? (w ? in_ptr(F, 21) : in_ptr(F, 20)) : (w ? in_ptr(F, 18) : in_ptr(F, 17)) + (size_t)e * 1024 * 256;
        bf16_t* db = e < 0 ? (bf16_t*)(ws + WS_WSGU) : (bf16_t*)(ws + WS_WGU) + (size_t)e * 512 * 1024;
        r.src = base + (size_t)kb * 64 * 256 + nb * 32; r.dst = db + (size_t)map_gu(nb * 32, w) * 1024 + kb * 64; }
    else { const int kb = qq / 32, nb = qq % 32; r.N = 1024; r.K = 256; r.scale = 16.f;
        const float* base = e < 0 ? in_ptr(F, 22) : in_ptr(F, 19) + (size_t)e * 256 * 1024;
        bf16_t* db = e < 0 ? (bf16_t*)(ws + WS_WSD) : (bf16_t*)(ws + WS_WD) + (size_t)e * 1024 * 256;
        r.src = base + (size_t)kb * 64 * 1024 + nb * 32; r.dst = db + (size_t)(nb * 32) * 256 + kb * 64; }
    return r;
}
constexpr int P0_NITEMS = 16 * 80 + 16 * 32 + 16 * 2 + 65 * 3 * 128;
constexpr int P0_TAIL_ITEMS = 128 * NWAVES * 4;
__device__ __forceinline__ void p0_transpose_range(Frame& F, const int lo, const int hi, const int gw, const int NGW) {
    LAS float* scr = (LAS float*)(F.lds + F.wave * 16384);
    const int lane = lane_id();
    constexpr int NITEMS = P0_NITEMS;
    {
        float cv[32], nv[32];
        int it = lo + gw;
        P0Item cur = p0_decode(F, it < hi ? it : 0);
        if (it < hi) {
#pragma unroll
            for (int i = 0; i < 32; ++i) cv[i] = __builtin_nontemporal_load(cur.src + (size_t)(2 * i + (lane >> 5)) * cur.N + (lane & 31));
        }
        for (; it < hi; it += NGW) {
            const int nit = it + NGW; const bool hn = nit < hi;
            const P0Item nx = p0_decode(F, hn ? nit : 0);
            if (hn) {
#pragma unroll
                for (int i = 0; i < 32; ++i) nv[i] = __builtin_nontemporal_load(nx.src + (size_t)(2 * i + (lane >> 5)) * nx.N + (lane & 31));
            }
#pragma unroll
            for (int i = 0; i < 32; ++i) scr[(2 * i + (lane >> 5)) * 33 + (lane & 31)] = cv[i];
            asm volatile("s_waitcnt lgkmcnt(0)" ::: "memory");
            const int c = lane & 7;
#pragma unroll
            for (int j = 0; j < 4; ++j) { const int n = (lane >> 3) + 8 * j; const LAS float* s = scr + (8 * c) * 33 + n;
                const float sc = cur.scale;
                u32x4 o; o.x = cvt_pk_bf16(s[0 * 33] * sc, s[1 * 33] * sc); o.y = cvt_pk_bf16(s[2 * 33] * sc, s[3 * 33] * sc); o.z = cvt_pk_bf16(s[4 * 33] * sc, s[5 * 33] * sc); o.w = cvt_pk_bf16(s[6 * 33] * sc, s[7 * 33] * sc);
                __builtin_nontemporal_store(o, (u32x4*)(cur.dst + (size_t)n * cur.K + 8 * c)); }
            asm volatile("s_waitcnt lgkmcnt(0)" ::: "memory");
            cur = nx;
#pragma unroll
            for (int i = 0; i < 32; ++i) cv[i] = nv[i];
        }
    }
    (void)NITEMS;
}
__device__ __forceinline__ void p0_prologue(Frame& F) {
    const int gw = F.vcu * NWAVES + F.wave, NGW = F.G * NWAVES, lane = lane_id();
    unsigned char* ws = F.ws;
    p0_transpose_range(F, 0, 16 * 80 + 16 * 32 + 16 * 2 + 3 * 128, gw, NGW);
    { const int gt = F.vcu * NTHREADS + F.wave * 64 + lane, NGT = F.G * NTHREADS; const f32x4* x4 = (const f32x4*)in_ptr(F, 0); u32x4* xb = (u32x4*)(ws + WS_XB);
      for (int i = gt; i < M_TOK * D_MODEL / 8; i += NGT) { const f32x4 a = x4[2 * i], b = x4[2 * i + 1];
          u32x4 o; o.x = cvt_pk_bf16(a[0], a[1]); o.y = cvt_pk_bf16(a[2], a[3]); o.z = cvt_pk_bf16(b[0], b[1]); o.w = cvt_pk_bf16(b[2], b[3]); xb[i] = o; }
      const int* pos = (const int*)in_ptr(F, 1); float* rope = (float*)(ws + WS_ROPE);
      for (int i = gt; i < M_TOK * 8; i += NGT) { const int t = i >> 3, k = i & 7; const float inv = powf(500000.0f, -(float)(2 * k) / 16.0f); const float ang = (float)pos[t] * inv;
          rope[t * 16 + k] = cosf(ang); rope[t * 16 + 8 + k] = sinf(ang); }
      if (gt == 0) { const float *q1 = in_ptr(F, 3), *k1 = in_ptr(F, 4), *q2 = in_ptr(F, 5), *k2 = in_ptr(F, 6); float a = 0.f, b = 0.f;
          for (int i = 0; i < 64; ++i) { a += q1[i] * k1[i]; b += q2[i] * k2[i]; } ((float*)(ws + WS_SMALL))[0] = expf(a) - expf(b) + LAMBDA_INIT; }
    }
}

struct EpiP1 {
    static constexpr bool PERM = true;
    bf16_t *Qimg, *Kimg, *Hc; const float* rope; int dry;
    __device__ __forceinline__ void operator()(const f32x4 (&acc)[2][2][4][2], const pg8::Unit& u, int wr, int wc, int fr_in, int fq_in) const {
        int fr = fr_in, fq = fq_in; asm volatile("" : "+v"(fr), "+v"(fq));
        if (dry) { _Pragma("unroll") for (int ai = 0; ai < 2; ++ai) _Pragma("unroll") for (int bj = 0; bj < 2; ++bj) _Pragma("unroll") for (int m = 0; m < 4; ++m) asm volatile("" :: "v"(acc[ai][bj][m][0]), "v"(acc[ai][bj][m][1])); return; }
        const int pn = u.pn;
        if (pn < 4) {
            bf16_t* img = pn < 2 ? Qimg : Kimg; const float sc = pn < 2 ? QSCALE : 1.f; const bool roped = (wc & 1) == 0;
#pragma unroll
            for (int ai = 0; ai < 2; ++ai)
#pragma unroll
                for (int m = 0; m < 4; ++m) {
                    const int row = u.pm * 256 + ai * 128 + wr * 64 + m * 16 + fr, b = row >> 12, sp = row & 4095;
                    f32x4 c0, c1, s0, s1;
                    if (roped) { const f32x4* rp = (const f32x4*)(rope + (size_t)row * 16); c0 = rp[0]; c1 = rp[1]; s0 = rp[2]; s1 = rp[3]; }
#pragma unroll
                    for (int bj = 0; bj < 2; ++bj) {
                        const int cc = (pn & 1) * 256 + bj * 128 + wc * 32 + fq * 8, h = cc >> 7, c2 = (cc >> 6) & 1, d0 = cc & 63;
                        f32x4 v0 = acc[ai][bj][m][0], v1 = acc[ai][bj][m][1];
                        if (roped) {
                            f32x4 p0, p1;
#pragma unroll
                            for (int j = 0; j < 4; ++j) { p0[j] = __shfl_xor(v0[j], 16); p1[j] = __shfl_xor(v1[j], 16); }
                            if (fq == 0) { v0 = v0 * c0 - p0 * s0; v1 = v1 * c1 - p1 * s1; }
                            else if (fq == 1) { v0 = v0 * c0 + p0 * s0; v1 = v1 * c1 + p1 * s1; }
                        }
                        v0 = v0 * sc; v1 = v1 * sc;
                        u32x4 w; w.x = cvt_pk_bf16(v0[0], v0[1]); w.y = cvt_pk_bf16(v0[2], v0[3]); w.z = cvt_pk_bf16(v1[0], v1[1]); w.w = cvt_pk_bf16(v1[2], v1[3]);
                        const size_t off = (size_t)((b * 4 + h) * 2 + c2) * (4096 * 64) + (size_t)(sp >> 5) * 2048 + (d0 >> 4) * 512 + ((d0 >> 3) & 1) * 256 + (sp & 31) * 8;
                        *(u32x4*)(img + off) = w;
                    }
                }
        } else {
#pragma unroll
            for (int ai = 0; ai < 2; ++ai)
#pragma unroll
                for (int m = 0; m < 4; ++m) {
                    const int row = u.pm * 256 + ai * 128 + wr * 64 + m * 16 + fr; const int ch0 = (pn - 6) * 128 + wc * 32 + fq * 8;
                    f32x4 h0, h1;
#pragma unroll
                    for (int j = 0; j < 4; ++j) { h0[j] = acc[ai][0][m][0][j] * sigmoidf_(acc[ai][1][m][0][j]); h1[j] = acc[ai][0][m][1][j] * sigmoidf_(acc[ai][1][m][1][j]); }
                    u32x4 w; w.x = cvt_pk_bf16(h0[0], h0[1]); w.y = cvt_pk_bf16(h0[2], h0[3]); w.z = cvt_pk_bf16(h1[0], h1[1]); w.w = cvt_pk_bf16(h1[2], h1[3]);
                    *(u32x4*)(Hc + (size_t)row * 512 + ch0) = w;
                }
        }
    }
};

struct EpiP1V {
    static constexpr bool PERM = true;
    bf16_t* Vimg;
    __device__ __forceinline__ void operator()(const f32x4 (&acc)[2][2][4][2], const pg8::Unit& u, int wr, int wc, int fr_in, int fq_in) const {
        int fr = fr_in, fq = fq_in; asm volatile("" : "+v"(fr), "+v"(fq));
        const int pn = u.pn;
        {
#pragma unroll
            for (int ai = 0; ai < 2; ++ai)
#pragma unroll
                for (int m = 0; m < 4; ++m) {
                    const int tok = u.pm * 256 + ai * 128 + wr * 64 + m * 16 + fq * 4, b = tok >> 12, sp = tok & 4095;
#pragma unroll
                    for (int bj = 0; bj < 2; ++bj)
#pragma unroll
                        for (int n = 0; n < 2; ++n) {
                            const int col = (pn - 4) * 256 + bj * 128 + wc * 32 + 8 * (fr >> 2) + 4 * n + (fr & 3), h = col >> 7, dv = col & 127;
                            const f32x4 v = acc[ai][bj][m][n];
                            u32x2 w; w.x = cvt_pk_bf16(v[0], v[1]); w.y = cvt_pk_bf16(v[2], v[3]);
                            const size_t off = (size_t)(b * 4 + h) * (4096 * 128) + (size_t)(sp >> 6) * 8192 + ((sp >> 4) & 3) * 2048 + (dv >> 5) * 512 + ((sp >> 2) & 1) * 256 + (dv & 31) * 8 + ((sp >> 3) & 1) * 4;
                            *(u32x2*)(Vimg + off) = w;
                        }
                }
        }
    }
};

__device__ __forceinline__ float exp2_(float x) { return __builtin_amdgcn_exp2f(x); }
__device__ __forceinline__ void glds16(const void* gsrc, unsigned lds_dst) { unsigned keep;
    asm volatile("s_mov_b32 %0, m0\n\ts_mov_b32 m0, %2\n\ts_nop 0\n\tglobal_load_lds_dwordx4 %1, off\n\ts_mov_b32 m0, %0" : "=&s"(keep) : "v"(gsrc), "s"(lds_dst) : "memory"); }
__device__ __forceinline__ void glds16_nt(const void* gsrc, unsigned lds_dst) { unsigned keep;
    asm volatile("s_mov_b32 %0, m0\n\ts_mov_b32 m0, %2\n\ts_nop 0\n\tglobal_load_lds_dwordx4 %1, off nt\n\ts_mov_b32 m0, %0" : "=&s"(keep) : "v"(gsrc), "s"(lds_dst) : "memory"); }
constexpr int W2_LO = 16 * 80 + 16 * 32 + 16 * 2 + 3 * 128;
constexpr int W2_LDS = 98304;
struct WHalf { const float* src; bf16_t* dst; int N, K; float scale; };
__device__ __forceinline__ int w2_hi(const Frame& F) { return P0_NITEMS - (F.G == 256 ? P0_TAIL_ITEMS : 0); }
__device__ __forceinline__ bool w2_decode(const Frame& F, const int ord, WHalf& h) {
    const int it = W2_LO + F.vcu * NWAVES + F.wave + (ord >> 1) * (F.G * NWAVES);
    if (it >= w2_hi(F)) return false;
    const int q = it - W2_LO, e = q / 384, r = q - e * 384, w = r >> 7, qq = r & 127, k0 = 32 * (ord & 1);
    const bool dn = w == 2;
    const int kb = dn ? qq >> 5 : qq >> 3, nb = dn ? qq & 31 : qq & 7;
    h.N = dn ? 1024 : 256; h.K = dn ? 256 : 1024; h.scale = dn ? 16.f : 1.f;
    h.src = in_ptr(F, 17 + w) + (size_t)e * 262144 + (size_t)((kb * 64 + k0) * h.N + nb * 32);
    h.dst = (bf16_t*)(F.ws + (dn ? WS_WD : WS_WGU)) + (size_t)e * (dn ? 262144 : 524288) + (size_t)((dn ? nb * 32 : map_gu(nb * 32, w)) * h.K + kb * 64 + k0);
    return true;
}
__device__ __forceinline__ void w2_dma(const WHalf& h, const unsigned ldsbuf) {
    const int lane = lane_id();
#pragma unroll
    for (int q = 0; q < 4; ++q) { const int rho = 8 * q + (lane >> 3), k = rho ^ ((rho >> 4) & 1);
        glds16_nt(h.src + (size_t)k * h.N + 4 * (lane & 7), (unsigned)__builtin_amdgcn_readfirstlane((int)(ldsbuf + q * 1024))); }
}
__device__ __forceinline__ void w2_proc(const WHalf& h, const LAS unsigned char* buf) {
    const int lane = lane_id(), n = lane & 31, hh = lane >> 5;
    const LAS float* be = (const LAS float*)(buf + n * 4 + hh * 2048 + hh * 128);
    const LAS float* bo = (const LAS float*)(buf + n * 4 + hh * 2048 - hh * 128);
    float v[16];
#pragma unroll
    for (int t = 0; t < 16; ++t) v[t] = ((t & 1) ? bo : be)[t * 32];
    const float sc = h.scale;
    u32x4 o0, o1;
    o0.x = cvt_pk_bf16(v[0] * sc, v[1] * sc); o0.y = cvt_pk_bf16(v[2] * sc, v[3] * sc); o0.z = cvt_pk_bf16(v[4] * sc, v[5] * sc); o0.w = cvt_pk_bf16(v[6] * sc, v[7] * sc);
    o1.x = cvt_pk_bf16(v[8] * sc, v[9] * sc); o1.y = cvt_pk_bf16(v[10] * sc, v[11] * sc); o1.z = cvt_pk_bf16(v[12] * sc, v[13] * sc); o1.w = cvt_pk_bf16(v[14] * sc, v[15] * sc);
    bf16_t* d = h.dst + (size_t)n * h.K + 16 * hh;
    __builtin_nontemporal_store(o0, (u32x4*)d); __builtin_nontemporal_store(o1, (u32x4*)(d + 8));
}
__device__ __forceinline__ void attn_unit(Frame& F, const int bh, const int qb, const float lam, int& wk) {
    const int lane = lane_id(), wave = F.wave, tid = wave * 64 + lane, sub = wave >> 2, wq = wave & 3, hi = lane >> 5;
    const bf16_t* Kg0 = (const bf16_t*)(F.ws + WS_KIMG) + (size_t)(bh * 2) * 262144 + tid * 8;
    const bf16_t* Kg1 = Kg0 + 262144;
    const bf16_t* Vg = (const bf16_t*)(F.ws + WS_VIMG) + (size_t)bh * 524288 + tid * 8;
    const bf16_t* Qg = (const bf16_t*)(F.ws + WS_QIMG) + (size_t)(bh * 2 + sub) * 262144 + (size_t)(qb * 4 + wq) * 2048 + lane * 8;
    LAS unsigned char* lds = F.lds;
    bf16x8 q[4];
#pragma unroll
    for (int s = 0; s < 4; ++s) q[s] = *(const bf16x8*)(Qg + s * 512);
    const int nt = 2 * qb + 2, cq = 2 * qb + (wq >> 1);
    const unsigned lds0 = (unsigned)(unsigned long)lds;
#define ATT_DMA(j, SO) do { const unsigned _d = lds0 + (unsigned)(SO) + (unsigned)wave * 1024u; \
        glds16(Kg0 + (size_t)(j) * 4096, (unsigned)__builtin_amdgcn_readfirstlane((int)_d)); \
        glds16(Kg1 + (size_t)(j) * 4096, (unsigned)__builtin_amdgcn_readfirstlane((int)(_d + 8192u))); \
        glds16(Vg + (size_t)(j) * 8192, (unsigned)__builtin_amdgcn_readfirstlane((int)(_d + 16384u))); \
        glds16(Vg + (size_t)(j) * 8192 + 4096, (unsigned)__builtin_amdgcn_readfirstlane((int)(_d + 24576u))); } while (0)
#define ATT_BAR() do { asm volatile("s_waitcnt vmcnt(0) lgkmcnt(0)" ::: "memory"); __builtin_amdgcn_s_barrier(); asm volatile("" ::: "memory"); } while (0)
#define ATT_BAR4() do { asm volatile("s_waitcnt vmcnt(4) lgkmcnt(0)" ::: "memory"); __builtin_amdgcn_s_barrier(); asm volatile("" ::: "memory"); } while (0)
#define ATT_BARN(N) do { asm volatile("s_waitcnt vmcnt(" #N ") lgkmcnt(0)" ::: "memory"); __builtin_amdgcn_s_barrier(); asm volatile("" ::: "memory"); } while (0)
    asm volatile("s_waitcnt vmcnt(0)" : "+v"(q[0]), "+v"(q[1]), "+v"(q[2]), "+v"(q[3]));
    ATT_DMA(0, 0); ATT_DMA(1, 32768);
    ATT_BAR4();
    f32x16 o[4];
#pragma unroll
    for (int d = 0; d < 4; ++d)
#pragma unroll
        for (int r = 0; r < 16; ++r) o[d][r] = 0.f;
    float m = 0.f, l = 0.f;
    f32x16 negm;
#pragma unroll
    for (int r = 0; r < 16; ++r) negm[r] = 0.f;
    int so_cur = 0, so_n1 = 32768, so_n2 = 65536;
    bool wpend = false;
    const LAS unsigned char* wbuf = lds + W2_LDS + wave * 4096;
    int wprev = 0;
    bf16_t* wdst = nullptr; int wK = 0; float wsc = 1.f;
    const int wpar = 0;
    for (int j = 0; j < nt; ++j) {
        if (j + 2 < nt) ATT_DMA(j + 2, so_n2);
        int wops = 0;
        if ((j & 1) == wpar) {
            if (wpend) {
                if (j + 2 < nt) asm volatile("s_waitcnt vmcnt(8)" ::: "memory"); else asm volatile("s_waitcnt vmcnt(4)" ::: "memory");
                WHalf h; h.dst = wdst; h.K = wK; h.scale = wsc; w2_proc(h, wbuf); wpend = false; wops = 2; asm volatile("s_waitcnt lgkmcnt(0)" ::: "memory"); }
            if (j + 2 < nt) { WHalf h; if (w2_decode(F, wk, h)) { w2_dma(h, lds0 + W2_LDS + (unsigned)wave * 4096u); ++wk; wpend = true; wops += 4; wdst = h.dst; wK = h.K; wsc = h.scale; } }
        }
        if (j <= cq) {
            const LAS unsigned char* kb = lds + so_cur + sub * 8192 + lane * 16;
            const LAS unsigned char* vb = lds + so_cur + 16384 + lane * 16;
            f32x16 s0 = negm, s1 = negm;
            { bf16x8 kf[8];
#pragma unroll
              for (int i = 0; i < 8; ++i) kf[i] = *(const LAS bf16x8*)(kb + i * 1024);
  #pragma unroll
              for (int s = 0; s < 4; ++s) {
                s0 = __builtin_amdgcn_mfma_f32_32x32x16_bf16(kf[s], q[s], s0, 0, 0, 0);
                s1 = __builtin_amdgcn_mfma_f32_32x32x16_bf16(kf[4 + s], q[s], s1, 0, 0, 0);
              } }
            bf16x8 va[8];
#pragma unroll
            for (int i = 0; i < 8; ++i) va[i] = *(const LAS bf16x8*)(vb + i * 1024);
            int mi = max(__float_as_int(s0[0]), __float_as_int(s1[0]));
#pragma unroll
            for (int r = 1; r < 16; ++r) mi = max(mi, max(__float_as_int(s0[r]), __float_as_int(s1[r])));
            mi = max(mi, __shfl_xor(mi, 32));
            if (j == 0 || __any(mi > 0x41000000)) {
                float dl;
                if (j == 0) {
                    float mx = fmaxf(s0[0], s1[0]);
#pragma unroll
                    for (int r = 1; r < 16; ++r) mx = fmaxf(mx, fmaxf(s0[r], s1[r]));
                    dl = fmaxf(mx, __shfl_xor(mx, 32));
                } else dl = fmaxf(__int_as_float(mi), 0.f);
                const float f = exp2_(-dl);
                m += dl; l *= f;
#pragma unroll
                for (int r = 0; r < 16; ++r) { s0[r] -= dl; s1[r] -= dl; negm[r] = -m; }
                if (j != 0) {
#pragma unroll
                    for (int d = 0; d < 4; ++d)
#pragma unroll
                        for (int r = 0; r < 16; ++r) o[d][r] *= f;
                }
            }
#pragma unroll
            for (int r = 0; r < 16; ++r) { s0[r] = exp2_(s0[r]); s1[r] = exp2_(s1[r]); }
            { float a0 = s0[0] + s1[0], a1 = s0[1] + s1[1], a2 = s0[2] + s1[2], a3 = s0[3] + s1[3];
#define ATT_ACC(a, x) do { a += (x); asm("" : "+v"(a)); } while (0)
#pragma unroll
              for (int r = 4; r < 16; r += 4) { ATT_ACC(a0, s0[r]); ATT_ACC(a1, s0[r + 1]); ATT_ACC(a2, s0[r + 2]); ATT_ACC(a3, s0[r + 3]); ATT_ACC(a0, s1[r]); ATT_ACC(a1, s1[r + 1]); ATT_ACC(a2, s1[r + 2]); ATT_ACC(a3, s1[r + 3]); }
#undef ATT_ACC
              l += (a0 + a1) + (a2 + a3); }
            bf16x8 pf[4];
#pragma unroll
            for (int ks = 0; ks < 4; ++ks) {
                u32x4 w;
                if (ks < 2) { const int b8 = 8 * ks; w.x = cvt_pk_bf16(s0[b8], s0[b8 + 1]); w.y = cvt_pk_bf16(s0[b8 + 2], s0[b8 + 3]); w.z = cvt_pk_bf16(s0[b8 + 4], s0[b8 + 5]); w.w = cvt_pk_bf16(s0[b8 + 6], s0[b8 + 7]); }
                else { const int b8 = 8 * (ks - 2); w.x = cvt_pk_bf16(s1[b8], s1[b8 + 1]); w.y = cvt_pk_bf16(s1[b8 + 2], s1[b8 + 3]); w.z = cvt_pk_bf16(s1[b8 + 4], s1[b8 + 5]); w.w = cvt_pk_bf16(s1[b8 + 6], s1[b8 + 7]); }
                pf[ks] = __builtin_bit_cast(bf16x8, w);
            }
            { bf16x8 vb2[8];
#pragma unroll
              for (int i = 0; i < 8; ++i) vb2[i] = *(const LAS bf16x8*)(vb + 8192 + i * 1024);
#pragma unroll
              for (int k2 = 0; k2 < 2; ++k2)
#pragma unroll
                for (int d = 0; d < 4; ++d) o[d] = __builtin_amdgcn_mfma_f32_32x32x16_bf16(va[k2 * 4 + d], pf[k2], o[d], 0, 0, 0);
  #pragma unroll
              for (int k2 = 0; k2 < 2; ++k2)
#pragma unroll
                for (int d = 0; d < 4; ++d) o[d] = __builtin_amdgcn_mfma_f32_32x32x16_bf16(vb2[k2 * 4 + d], pf[2 + k2], o[d], 0, 0, 0);
            }
        }
        { const int wall = ((j & 1) != wpar) ? wprev : wops;
          if (j + 2 < nt) { if (wall == 6) ATT_BARN(10); else if (wall == 4) ATT_BARN(8); else if (wall == 2) ATT_BARN(6); else ATT_BAR4(); } else ATT_BAR();
          wprev = wops; }
        { const int tmp = so_cur; so_cur = so_n1; so_n1 = so_n2; so_n2 = tmp; }
    }
    l += __shfl_xor(l, 32);
    const float inv = 1.f / l;
    LAS float* xo = (LAS float*)lds + (size_t)(wq * 64) * 64 + lane;
    if (sub == 1) {
#pragma unroll
        for (int d = 0; d < 4; ++d)
#pragma unroll
            for (int r = 0; r < 16; ++r) xo[(d * 16 + r) * 64] = o[d][r] * inv;
    }
    ATT_BAR();
    if (sub == 0) {
        float ss = 0.f;
#pragma unroll
        for (int d = 0; d < 4; ++d)
#pragma unroll
            for (int r = 0; r < 16; ++r) { const float v = o[d][r] * inv - lam * xo[(d * 16 + r) * 64]; o[d][r] = v; ss += v * v; }
        ss += __shfl_xor(ss, 32);
        const float rn = rsqrtf(ss * (1.f / 128.f) + LN_EPS) * (1.f - LAMBDA_INIT);
        const float* g = in_ptr(F, 7);
        const int h = bh & 3, b = bh >> 2;
        bf16_t* orow = (bf16_t*)(F.ws + WS_MIXIN) + (size_t)(b * 4096 + qb * 128 + wq * 32 + (lane & 31)) * 1024 + h * 128 + 4 * hi;
#pragma unroll
        for (int d = 0; d < 4; ++d)
#pragma unroll
            for (int i = 0; i < 4; ++i) {
                const f32x4 g4 = *(const f32x4*)(g + 32 * d + 8 * i + 4 * hi);
                u32x2 w; w.x = cvt_pk_bf16(o[d][4 * i] * rn * g4[0], o[d][4 * i + 1] * rn * g4[1]); w.y = cvt_pk_bf16(o[d][4 * i + 2] * rn * g4[2], o[d][4 * i + 3] * rn * g4[3]);
                *(u32x2*)(orow + 32 * d + 8 * i) = w;
            }
    }
    ATT_BAR();
#undef ATT_DMA
#undef ATT_BAR4
#undef ATT_BARN
}

__device__ __forceinline__ void conv_tile(Frame& F, const int ct) {
    const int lane = lane_id(), wave = F.wave, tid = wave * 64 + lane;
    LAS unsigned char* lds = F.lds;
    const bf16_t* Hc = (const bf16_t*)(F.ws + WS_HC);
    const int t0 = ct * 64, s0 = t0 & 4095;
    for (int p = tid; p < 94 * 64; p += NTHREADS) { const int row = p >> 6, c16 = p & 63; u32x4 v = (u32x4){0u, 0u, 0u, 0u};
        if (s0 - 30 + row >= 0) v = *(const u32x4*)(Hc + (size_t)(t0 - 30 + row) * 512 + c16 * 8);
        *(LAS u32x4*)(lds + row * 1024 + c16 * 16) = v; }
    ATT_BAR();
    const int cp = tid & 255, th = tid >> 8, c = 2 * cp;
    const float* cw = in_ptr(F, 8);
    float w0[31], w1[31];
#pragma unroll
    for (int w = 0; w < 31; ++w) { const f32x2 ww = *(const f32x2*)(cw + w * 512 + c); w0[w] = ww[0]; w1[w] = ww[1]; }
    const f32x2 bias = *(const f32x2*)(in_ptr(F, 9) + c);
    const f32x2 lg = *(const f32x2*)(in_ptr(F, 10) + c), lb = *(const f32x2*)(in_ptr(F, 11) + c);
    LAS float* red = (LAS float*)(lds + 98304);
    LAS float* tot = red + 256;
    for (int hf = 0; hf < 2; ++hf) {
        float a0[16], a1[16];
#pragma unroll
        for (int it = 0; it < 4; ++it) {
#pragma unroll
            for (int oo = 0; oo < 4; ++oo) { a0[it * 4 + oo] = bias[0]; a1[it * 4 + oo] = bias[1]; }
            const LAS unsigned char* base = lds + (th * 32 + hf * 16 + it * 4) * 1024 + cp * 4;
#pragma unroll
            for (int wp = 0; wp < 34; ++wp) { const unsigned hv = *(const LAS unsigned*)(base + wp * 1024); const float x0 = bflo(hv), x1 = bfhi(hv);
#pragma unroll
                for (int oo = 0; oo < 4; ++oo) { const int w = wp - oo; if (w >= 0 && w < 31) { a0[it * 4 + oo] += x0 * w0[w]; a1[it * 4 + oo] += x1 * w1[w]; } } }
        }
        float v[32];
#pragma unroll
        for (int i = 0; i < 16; ++i) { v[2 * i] = a0[i] + a1[i]; v[2 * i + 1] = a0[i] * a0[i] + a1[i] * a1[i]; }
#pragma unroll
        for (int st = 0; st < 5; ++st) { const int half = 16 >> st, mask = 16 >> st; const bool up = (lane & mask) != 0;
#pragma unroll
            for (int i = 0; i < 16; ++i) if (i < half) { const float send = up ? v[i] : v[i + half], keep = up ? v[i + half] : v[i]; v[i] = keep + __shfl_xor(send, mask); } }
        v[0] += __shfl_xor(v[0], 32);
        if (lane < 32) red[wave * 32 + lane] = v[0];
        ATT_BAR();
        if (tid < 64) { const int hh = tid >> 5, vi = tid & 31; tot[tid] = red[(hh * 4 + 0) * 32 + vi] + red[(hh * 4 + 1) * 32 + vi] + red[(hh * 4 + 2) * 32 + vi] + red[(hh * 4 + 3) * 32 + vi]; }
        ATT_BAR();
        bf16_t* orow = (bf16_t*)(F.ws + WS_MIXIN) + (size_t)(t0 + th * 32 + hf * 16) * 1024 + 512 + c;
#pragma unroll
        for (int i = 0; i < 16; ++i) { const float mu = tot[th * 32 + 2 * i] * (1.f / 512.f), var = tot[th * 32 + 2 * i + 1] * (1.f / 512.f) - mu * mu; const float rs = rsqrtf(var + LN_EPS);
            float y0 = (a0[i] - mu) * rs * lg[0] + lb[0], y1 = (a1[i] - mu) * rs * lg[1] + lb[1]; y0 = y0 * sigmoidf_(y0); y1 = y1 * sigmoidf_(y1);
            *(unsigned*)(orow + (size_t)i * 1024) = cvt_pk_bf16(y0, y1); }
        ATT_BAR();
    }
}
#undef ATT_BAR

__device__ __forceinline__ void p2_phase(Frame& F) {
    const float lam = ((const float*)(F.ws + WS_SMALL))[0];
    int wk = 0;
    for (int p = F.vcu; p < 256; p += F.G) { const int bh = p >> 4, pi = p & 15; attn_unit(F, bh, 31 - pi, lam, wk); attn_unit(F, bh, pi, lam, wk); }
    for (;;) {
        WHalf h; if (!w2_decode(F, wk, h)) break;
        w2_dma(h, (unsigned)(unsigned long)F.lds + W2_LDS + (unsigned)F.wave * 4096u); ++wk;
        asm volatile("s_waitcnt vmcnt(0)" ::: "memory");
        w2_proc(h, F.lds + W2_LDS + F.wave * 4096);
        asm volatile("s_waitcnt lgkmcnt(0)" ::: "memory");
    }
    __syncthreads();
    for (int ct = F.vcu; ct < M_TOK / 64; ct += F.G) { conv_tile(F, ct); if constexpr ((MK_DUP >> 21) & 1) conv_tile(F, ct); }
}


struct EpiP3 {
    static constexpr bool PERM = true;
    const float* x; bf16_t* Y1; float* yst;
    __device__ __forceinline__ void operator()(const f32x4 (&acc)[2][2][4][2], const pg8::Unit& u, int wr, int wc, int fr_in, int fq_in) const {
        int fr = fr_in, fq = fq_in; asm volatile("" : "+v"(fr), "+v"(fq));
#pragma unroll
        for (int ai = 0; ai < 2; ++ai)
#pragma unroll
            for (int m = 0; m < 4; ++m) {
                const size_t row = (size_t)(u.pm * 256 + ai * 128 + wr * 64 + m * 16 + fr);
                float s1 = 0.f, s2 = 0.f;
#pragma unroll
                for (int bj = 0; bj < 2; ++bj) {
                    const size_t off = row * 1024 + u.pn * 256 + bj * 128 + wc * 32 + fq * 8;
                    const u32x4 xw = *(const u32x4*)(Y1 + off);
                    const f32x4 x0 = {bflo(xw.x), bfhi(xw.x), bflo(xw.y), bfhi(xw.y)}, x1 = {bflo(xw.z), bfhi(xw.z), bflo(xw.w), bfhi(xw.w)};
                    const f32x4 y0 = x0 * ALPHA + acc[ai][bj][m][0], y1 = x1 * ALPHA + acc[ai][bj][m][1];
                    u32x4 w; w.x = cvt_pk_bf16(y0[0], y0[1]); w.y = cvt_pk_bf16(y0[2], y0[3]); w.z = cvt_pk_bf16(y1[0], y1[1]); w.w = cvt_pk_bf16(y1[2], y1[3]);
                    *(u32x4*)(Y1 + off) = w;
                    const float r0 = bflo(w.x), r1 = bfhi(w.x), r2 = bflo(w.y), r3 = bfhi(w.y), r4 = bflo(w.z), r5 = bfhi(w.z), r6 = bflo(w.w), r7 = bfhi(w.w);
                    s1 += ((r0 + r1) + (r2 + r3)) + ((r4 + r5) + (r6 + r7));
                    s2 += ((r0 * r0 + r1 * r1) + (r2 * r2 + r3 * r3)) + ((r4 * r4 + r5 * r5) + (r6 * r6 + r7 * r7));
                }
                s1 += __shfl_xor(s1, 16); s1 += __shfl_xor(s1, 32); s2 += __shfl_xor(s2, 16); s2 += __shfl_xor(s2, 32);
                if (fq == 0) *(f32x2*)(yst + (row * 16 + u.pn * 4 + wc) * 2) = (f32x2){s1, s2};
            }
    }
};

constexpr int P4_LOG = 0;
constexpr int P4_SC = 36864;
constexpr int P4_BS = 55296;
constexpr int P4_ST = 73728;
constexpr int P4_GS = 75776;
constexpr int P4_GF = 78848;
constexpr int P4_SE = 81920;
constexpr int P4_SR = 83968;
constexpr int P4_SG = 86016;
constexpr int P4_LC = 88064;
constexpr int P4_GB = 88320;
__device__ __forceinline__ void p4_unit(Frame& F, const int ut, const bool dry) {
    const int lane = lane_id(), wave = F.wave, tid = wave * 64 + lane, rg = wave & 3, kh = wave >> 2, r = lane & 15, q = lane >> 4;
    LAS unsigned char* lds = F.lds;
    const int row0 = ut * 64, rl = rg * 16 + r, row = row0 + rl;
    const bf16_t* yrow = (const bf16_t*)(F.ws + WS_Y1) + (size_t)row * 1024 + kh * 512 + q * 8;
    const float* gsrc = in_ptr(F, 13); const float* bsrc = in_ptr(F, 14);
    const float gv0 = gsrc[tid], gv1 = gsrc[tid + 512], bv0 = bsrc[tid], bv1 = bsrc[tid + 512];
    const f32x4* ps = (const f32x4*)((const float*)(F.ws + WS_YST) + (size_t)row * 32 + q * 8); const f32x4 sa = ps[0], sb = ps[1];
    asm volatile("" ::: "memory");
    u32x4 ywv[16];
#pragma unroll
    for (int s = 0; s < 16; ++s) ywv[s] = *(const u32x4*)(yrow + s * 32);
    asm volatile("" ::: "memory");
    float s1 = sa[0] + sa[2] + sb[0] + sb[2], s2 = sa[1] + sa[3] + sb[1] + sb[3];
    s1 += __shfl_xor(s1, 16); s1 += __shfl_xor(s1, 32); s2 += __shfl_xor(s2, 16); s2 += __shfl_xor(s2, 32);
    if (tid < 64) ((LAS int*)(lds + P4_LC))[tid] = 0;
    const float mean = s1 * (1.f / 1024.f);
    const float var = s2 * (1.f / 1024.f) - mean * mean;
    const float rstd = rsqrtf(var + LN_EPS);
    LAS float* gl = (LAS float*)(lds + P4_GB + 1024); LAS float* bl = gl + 1024;
    gl[tid] = gv0; gl[tid + 512] = gv1; bl[tid] = bv0; bl[tid + 512] = bv1;
    asm volatile("s_waitcnt lgkmcnt(0)" ::: "memory"); __builtin_amdgcn_s_barrier(); asm volatile("" ::: "memory");
    const LAS float* g = gl + kh * 512 + q * 8; const LAS float* bb = bl + kh * 512 + q * 8;
    bf16_t* x1row = (bf16_t*)((dry ? F.ws + 173 * MiB : (unsigned char*)F.out) + (size_t)row * 4096) + kh * 512 + q * 8;
    const bf16_t* wr = (const bf16_t*)(F.ws + WS_WR) + (size_t)r * 1024 + kh * 512 + q * 8;
    f32x4 acc[4];
#pragma unroll
    for (int gi = 0; gi < 4; ++gi) acc[gi] = (f32x4){0.f, 0.f, 0.f, 0.f};
    bf16x8 wfn[2][4];
#pragma unroll
    for (int h = 0; h < 2; ++h)
#pragma unroll
        for (int gi = 0; gi < 4; ++gi) wfn[h][gi] = *(const bf16x8*)(wr + (size_t)gi * 16 * 1024 + h * 32);
#pragma unroll
    for (int sp = 0; sp < 8; ++sp) {
        bf16x8 wfc[2][4];
#pragma unroll
        for (int h = 0; h < 2; ++h)
#pragma unroll
            for (int gi = 0; gi < 4; ++gi) wfc[h][gi] = wfn[h][gi];
        if (sp < 7) {
#pragma unroll
            for (int h = 0; h < 2; ++h)
#pragma unroll
                for (int gi = 0; gi < 4; ++gi) wfn[h][gi] = *(const bf16x8*)(wr + (size_t)gi * 16 * 1024 + (2 * sp + 2 + h) * 32);
        }
#pragma unroll
        for (int h = 0; h < 2; ++h) {
            const int s = 2 * sp + h;
            const u32x4 yw = ywv[s];
            const f32x4 a = (f32x4){bflo(yw.x), bfhi(yw.x), bflo(yw.y), bfhi(yw.y)}, b = (f32x4){bflo(yw.z), bfhi(yw.z), bflo(yw.w), bfhi(yw.w)};
            const f32x4 g0 = *(const LAS f32x4*)(g + s * 32), g1 = *(const LAS f32x4*)(g + s * 32 + 4), b0 = *(const LAS f32x4*)(bb + s * 32), b1 = *(const LAS f32x4*)(bb + s * 32 + 4);
            const f32x4 xa = (a - mean) * rstd * g0 + b0, xb = (b - mean) * rstd * g1 + b1;
            u32x4 w; w.x = cvt_pk_bf16(xa[0], xa[1]); w.y = cvt_pk_bf16(xa[2], xa[3]); w.z = cvt_pk_bf16(xb[0], xb[1]); w.w = cvt_pk_bf16(xb[2], xb[3]);
            *(u32x4*)(x1row + s * 32) = w;
            const bf16x8 xf = __builtin_bit_cast(bf16x8, w);
#pragma unroll
            for (int gi = 0; gi < 4; ++gi) acc[gi] = __builtin_amdgcn_mfma_f32_16x16x32_bf16(wfc[h][gi], xf, acc[gi], 0, 0, 0);
        }
        __builtin_amdgcn_sched_barrier(0);
    }
    if constexpr ((MK_DUP >> 18) & 1) { if (dry) { asm volatile("" :: "v"(acc[0]), "v"(acc[1]), "v"(acc[2]), "v"(acc[3])); return; } }
    LAS float* lg = (LAS float*)(lds + P4_LOG);
#pragma unroll
    for (int gi = 0; gi < 4; ++gi) *(LAS f32x4*)(lg + (kh * 64 + rl) * 68 + gi * 16 + q * 4) = acc[gi];
    asm volatile("s_waitcnt lgkmcnt(0)" ::: "memory"); __builtin_amdgcn_s_barrier(); asm volatile("" ::: "memory");
    LAS int* lc = (LAS int*)(lds + P4_LC); LAS int* gb = (LAS int*)(lds + P4_GB);
    const int t = tid >> 3, gq = tid & 7, lbase = lane & ~7;
    float sv[8], bv[8];
    { const float* rb = in_ptr(F, 16); float a = -INFINITY, b2 = -INFINITY;
#pragma unroll
      for (int jx = 0; jx < 8; ++jx) { const int e = gq * 8 + jx; const float s = 1.f / (1.f + __expf(-(lg[t * 68 + e] + lg[(64 + t) * 68 + e]))); sv[jx] = s; const float v = s + rb[e]; bv[jx] = v;
          if (v > a) { b2 = a; a = v; } else if (v > b2) b2 = v; }
      const float myg = a + b2; int grank = 0;
#pragma unroll
      for (int d = 1; d < 8; ++d) { const int og = (gq + d) & 7; const float o = __shfl(myg, lbase | og); grank += (o > myg || (o == myg && og < gq)) ? 1 : 0; }
      if (grank >= 4) {
#pragma unroll
          for (int jx = 0; jx < 8; ++jx) bv[jx] = -INFINITY; } }
    int my_e = 0; float my_s = 0.f;
#pragma unroll
    for (int r = 0; r < 8; ++r) {
        float m = bv[0]; int jm = 0; float sm = sv[0];
#pragma unroll
        for (int jx = 1; jx < 8; ++jx) if (bv[jx] > m) { m = bv[jx]; jm = jx; sm = sv[jx]; }
        int e = gq * 8 + jm;
#pragma unroll
        for (int k = 1; k < 8; k <<= 1) { const float om = __shfl_xor(m, k), os = __shfl_xor(sm, k); const int oe = __shfl_xor(e, k);
            if (om > m || (om == m && oe < e)) { m = om; e = oe; sm = os; } }
        if (gq == r) { my_e = e; my_s = sm; }
        if ((e >> 3) == gq) {
#pragma unroll
            for (int jx = 0; jx < 8; ++jx) if (jx == (e & 7)) bv[jx] = -INFINITY; }
    }
    float ssum = my_s;
#pragma unroll
    for (int k = 1; k < 8; k <<= 1) ssum += __shfl_xor(ssum, k);
    const float my_gate = my_s * (ROUTED_SCALE / ssum);
    const int my_rank = __hip_atomic_fetch_add(lc + my_e, 1, __ATOMIC_RELAXED, __HIP_MEMORY_SCOPE_WORKGROUP);
    asm volatile("s_waitcnt lgkmcnt(0)" ::: "memory"); __builtin_amdgcn_s_barrier(); asm volatile("" ::: "memory");
    if constexpr ((MK_DUP >> 19) & 1) { if (dry) return; }
    if (tid < 64) gb[tid] = (int)atomicAdd(F.ctl + CW_ECNT + (dry ? 32 : 0) + 64 * tid, (unsigned)lc[tid]);
    asm volatile("s_waitcnt vmcnt(0) lgkmcnt(0)" ::: "memory"); __builtin_amdgcn_s_barrier(); asm volatile("" ::: "memory");
    { const int pos = gb[my_e] + my_rank; const int pair = (row0 + t) * 8 + gq;
      unsigned char* wsd = F.ws + (dry ? 16 * MiB : 0);
      ((int*)(wsd + WS_ROWPAIR))[(size_t)my_e * M_TOK + pos] = pair; ((float*)(wsd + WS_GATE))[pair] = my_gate; ((int*)(wsd + WS_PAIRPOS))[pair] = (my_e << 16) | pos; }
    asm volatile("s_waitcnt lgkmcnt(0)" ::: "memory"); __builtin_amdgcn_s_barrier(); asm volatile("" ::: "memory");
}
__device__ __forceinline__ void p4_phase(Frame& F, const bool dry) { for (int ut = F.vcu; ut < M_TOK / 64; ut += F.G) p4_unit(F, ut, dry); }

constexpr int MT_OFF = RING_BYTES + 1024;
struct MoeTab { volatile LAS int* cnt; volatile LAS int* cs; volatile LAS int* up; };
__device__ __forceinline__ MoeTab moe_tab(Frame& F) { MoeTab T; T.cnt = (volatile LAS int*)(F.lds + MT_OFF); T.cs = T.cnt + 80; T.up = T.cs + 80; return T; }
__device__ __forceinline__ void moe_build_tab(Frame& F) {
    MoeTab T = moe_tab(F);
    if (F.wave == 0) {
        const int e = lane_id();
        const int c = (int)__hip_atomic_load(F.ctl + CW_ECNT + 64 * e, __ATOMIC_RELAXED, __HIP_MEMORY_SCOPE_AGENT);
        const int tl = (c + 255) >> 8;
        int cs = c, up = tl;
#pragma unroll
        for (int o = 1; o < 64; o <<= 1) { const int a = __shfl_up(cs, o), b = __shfl_up(up, o); if (e >= o) { cs += a; up += b; } }
        T.cnt[e] = c; T.cs[e] = cs - c; T.up[e] = up - tl;
        if (e == 63) { T.cnt[64] = M_TOK; T.cs[64] = cs; T.up[64] = up; T.cs[65] = cs + M_TOK; T.up[65] = up + M_TOK / 256; }
    }
    __syncthreads();
}
template <bool DOWN> struct MoeSched {
    static constexpr int UF = DOWN ? 4 : 2;
    MoeTab T; int G, c, ntot; const char* Wr; const char* Ws; const int* rowpair;
    __device__ void init(Frame& F) { T = moe_tab(F); G = F.G; c = (int)blockIdx.x; ntot = T.up[65] * UF; rowpair = (const int*)(F.ws + WS_ROWPAIR);
        Wr = (const char*)(F.ws + (DOWN ? WS_WD : WS_WGU)); Ws = (const char*)(F.ws + (DOWN ? WS_WSD : WS_WSGU)); }
    __device__ bool next(int i, pg8::Unit& u) const {
        const long L = (long)i * G + c; if (L >= ntot) return false;
        int w = (int)L; { const int q = ntot / 8, r = ntot % 8, xcd = w % 8, off = w / 8; w = (xcd < r ? xcd * (q + 1) : r * (q + 1) + (xcd - r) * q) + off; }
        const int ln = lane_id();
        const int upl = T.up[ln], cntl = T.cnt[ln], csl = T.cs[ln];
        const unsigned long long below = __ballot(upl * UF <= w);
        int e = 63 - __builtin_clzll(below | 1ull);
        int cnt = __builtin_amdgcn_readlane(cntl, e), cse = __builtin_amdgcn_readlane(csl, e), upe = __builtin_amdgcn_readlane(upl, e);
        if (w >= T.up[64] * UF) { e = 64; cnt = M_TOK; cse = T.cs[64]; upe = T.up[64]; }
        const int nte = (cnt + 255) >> 8, rem = w - upe * UF;
        u.e = e; u.pn = rem % UF; u.pm = rem / UF;     (void)nte; u.cnt = min(256, cnt - 256 * u.pm); u.arow0 = cse + 256 * u.pm;
        const size_t wbytes = DOWN ? (size_t)1024 * 256 * 2 : (size_t)512 * 1024 * 2;
        const size_t tile = DOWN ? (size_t)u.pn * 256 * 256 * 2 : (size_t)u.pn * 256 * 1024 * 2;
        u.Bp = (e < 64 ? Wr + (size_t)e * wbytes : Ws) + tile; return true;
    }
    __device__ __forceinline__ int arow(const pg8::Unit& u, int r) const {
        if (DOWN) return u.arow0 + r;
        if (u.e == 64) return 256 * u.pm + r;
        return r < u.cnt ? (rowpair[(size_t)u.e * M_TOK + 256 * u.pm + r] >> 3) : 0;
    }
};
__device__ __forceinline__ float siluf_(float x) { return x * __builtin_amdgcn_rcpf(1.f + __expf(-x)); }
struct EpiP6 {
    static constexpr bool PERM = true;
    bf16_t* H; int dry;
    __device__ __forceinline__ void operator()(const f32x4 (&acc)[2][2][4][2], const pg8::Unit& u, int wr, int wc, int fr_in, int fq_in) const {
        int fr = fr_in, fq = fq_in; asm volatile("" : "+v"(fr), "+v"(fq));
if (dry) { _Pragma("unroll") for (int ai = 0; ai < 2; ++ai) _Pragma("unroll") for (int bj = 0; bj < 2; ++bj) _Pragma("unroll") for (int m = 0; m < 4; ++m) asm volatile("" :: "v"(acc[ai][bj][m][0]), "v"(acc[ai][bj][m][1])); return; }
#pragma unroll
        for (int ai = 0; ai < 2; ++ai)
#pragma unroll
            for (int m = 0; m < 4; ++m) {
                const int row = ai * 128 + wr * 64 + m * 16 + fr;
                if (row < u.cnt) {
                    f32x4 h0, h1;
#pragma unroll
                    for (int j = 0; j < 4; ++j) { h0[j] = siluf_(acc[ai][0][m][0][j]) * acc[ai][1][m][0][j]; h1[j] = siluf_(acc[ai][0][m][1][j]) * acc[ai][1][m][1][j]; }
                    u32x4 w; w.x = cvt_pk_bf16(h0[0], h0[1]); w.y = cvt_pk_bf16(h0[2], h0[3]); w.z = cvt_pk_bf16(h1[0], h1[1]); w.w = cvt_pk_bf16(h1[2], h1[3]);
                    *(u32x4*)(H + (size_t)(u.arow0 + row) * 256 + u.pn * 128 + wc * 32 + fq * 8) = w;
                }
            }
    }
};
constexpr float Y8_INV = 1.f / 16.f, Y8_MAX = 440.f;
__device__ __forceinline__ unsigned pack_fp8x4(const f32x4 v) {
    const float a = __builtin_amdgcn_fmed3f(v[0], -Y8_MAX, Y8_MAX), b = __builtin_amdgcn_fmed3f(v[1], -Y8_MAX, Y8_MAX), c = __builtin_amdgcn_fmed3f(v[2], -Y8_MAX, Y8_MAX), d = __builtin_amdgcn_fmed3f(v[3], -Y8_MAX, Y8_MAX);
    int w = __builtin_amdgcn_cvt_pk_fp8_f32(a, b, 0, false); w = __builtin_amdgcn_cvt_pk_fp8_f32(c, d, w, true); return (unsigned)w;
}
struct EpiP7 {
    static constexpr bool PERM = true;
    unsigned char* Y8; unsigned char* SH8; int dry;
    __device__ __forceinline__ void operator()(const f32x4 (&acc)[2][2][4][2], const pg8::Unit& u, int wr, int wc, int fr_in, int fq_in) const {
        int fr = fr_in, fq = fq_in; asm volatile("" : "+v"(fr), "+v"(fq));
        if (dry) { _Pragma("unroll") for (int ai = 0; ai < 2; ++ai) _Pragma("unroll") for (int bj = 0; bj < 2; ++bj) _Pragma("unroll") for (int m = 0; m < 4; ++m) asm volatile("" :: "v"(acc[ai][bj][m][0]), "v"(acc[ai][bj][m][1])); return; }
        unsigned char* base = (u.e < 64 ? Y8 + (size_t)u.arow0 * 1024 : SH8 + (size_t)(256 * u.pm) * 1024) + u.pn * 256 + wc * 64 + fq * 16;
#pragma unroll
        for (int ai = 0; ai < 2; ++ai)
#pragma unroll
            for (int m = 0; m < 4; ++m) {
                const int row = ai * 128 + wr * 64 + m * 16 + fr;
                if (row < u.cnt) { u32x4 w; w.x = pack_fp8x4(acc[ai][0][m][0]); w.y = pack_fp8x4(acc[ai][0][m][1]); w.z = pack_fp8x4(acc[ai][1][m][0]); w.w = pack_fp8x4(acc[ai][1][m][1]);
                    *(u32x4*)(base + (size_t)row * 1024) = w; }
            }
    }
};
__device__ __forceinline__ void fp8x4_fma(float (&v)[16], const int b4, const unsigned w, const float g) {
    const f32x2 lo = __builtin_amdgcn_cvt_pk_f32_fp8((int)w, false), hi = __builtin_amdgcn_cvt_pk_f32_fp8((int)w, true);
    v[b4] += g * lo[0]; v[b4 + 1] += g * lo[1]; v[b4 + 2] += g * hi[0]; v[b4 + 3] += g * hi[1];
}
__device__ __forceinline__ void p8_combine(Frame& F, const bool dry) {
    const int gw = F.vcu * NWAVES + F.wave, NGW = F.G * NWAVES, lane = lane_id();
    const unsigned char* Y8 = (const unsigned char*)(F.ws + WS_YH); const unsigned char* SH8 = (const unsigned char*)(F.ws + WS_SH);
    const int* pairpos = (const int*)(F.ws + WS_PAIRPOS); const float* gate = (const float*)(F.ws + WS_GATE); MoeTab T = moe_tab(F);
    const int cb = 256 * (lane >> 4) + 32 * ((lane >> 2) & 3) + 8 * (lane & 3);
    const float* g = in_ptr(F, 23) + cb; const float* b = in_ptr(F, 24) + cb;
    int ppn = 0; float ggn = 0.f;
    u32x4 xaN, xbN, ywN[9]; float gkN[9];
#define P8_ROWS(tt, pp_, gg_) do { const unsigned char* xr_ = (const unsigned char*)F.out + (size_t)(tt) * 4096; \
        xaN = *(const u32x4*)(xr_ + cb * 2); xbN = *(const u32x4*)(xr_ + cb * 2 + 256); \
        const int crow_ = T.cs[(pp_) >> 16] + ((pp_) & 0xffff); \
        _Pragma("unroll") for (int k = 0; k < 8; ++k) { const int rk = __shfl(crow_, k); gkN[k] = __shfl((gg_) * Y8_INV, k); ywN[k] = __builtin_nontemporal_load((const u32x4*)(Y8 + (size_t)rk * 1024 + lane * 16)); } \
        ywN[8] = __builtin_nontemporal_load((const u32x4*)(SH8 + (size_t)(tt) * 1024 + lane * 16)); gkN[8] = Y8_INV; } while (0)
    if (gw < M_TOK) { const int pp0 = pairpos[(size_t)gw * 8 + (lane & 7)]; const float gg0 = gate[(size_t)gw * 8 + (lane & 7)];
        if (gw + NGW < M_TOK) { ppn = pairpos[(size_t)(gw + NGW) * 8 + (lane & 7)]; ggn = gate[(size_t)(gw + NGW) * 8 + (lane & 7)]; }
        P8_ROWS(gw, pp0, gg0); }
    for (int t = gw; t < M_TOK; t += NGW) {
        const u32x4 xa = xaN, xb = xbN; u32x4 yw[9]; float gk[9];
#pragma unroll
        for (int k = 0; k < 9; ++k) { yw[k] = ywN[k]; gk[k] = gkN[k]; }
        if (t + NGW < M_TOK) { const int pp1 = ppn; const float gg1 = ggn;
            if (t + 2 * NGW < M_TOK) { ppn = pairpos[(size_t)(t + 2 * NGW) * 8 + (lane & 7)]; ggn = gate[(size_t)(t + 2 * NGW) * 8 + (lane & 7)]; }
            P8_ROWS(t + NGW, pp1, gg1); }
        float v[16];
        v[0] = ALPHA * bflo(xa.x); v[1] = ALPHA * bfhi(xa.x); v[2] = ALPHA * bflo(xa.y); v[3] = ALPHA * bfhi(xa.y); v[4] = ALPHA * bflo(xa.z); v[5] = ALPHA * bfhi(xa.z); v[6] = ALPHA * bflo(xa.w); v[7] = ALPHA * bfhi(xa.w);
        v[8] = ALPHA * bflo(xb.x); v[9] = ALPHA * bfhi(xb.x); v[10] = ALPHA * bflo(xb.y); v[11] = ALPHA * bfhi(xb.y); v[12] = ALPHA * bflo(xb.z); v[13] = ALPHA * bfhi(xb.z); v[14] = ALPHA * bflo(xb.w); v[15] = ALPHA * bfhi(xb.w);
#pragma unroll
        for (int k = 0; k < 9; ++k) { fp8x4_fma(v, 0, yw[k].x, gk[k]); fp8x4_fma(v, 4, yw[k].y, gk[k]); fp8x4_fma(v, 8, yw[k].z, gk[k]); fp8x4_fma(v, 12, yw[k].w, gk[k]);
            if (k % 3 == 2) __builtin_amdgcn_sched_barrier(0); }
        float s = 0.f;
#pragma unroll
        for (int j = 0; j < 16; ++j) s += v[j];
        const float mean = wave_sum(s) * (1.f / 1024.f);
        float qq = 0.f;
#pragma unroll
        for (int j = 0; j < 16; ++j) { v[j] -= mean; qq += v[j] * v[j]; }
        const float rstd = rsqrtf(wave_sum(qq) * (1.f / 1024.f) + LN_EPS);
        float* od = (float*)(dry ? F.ws + 173 * MiB + (size_t)t * 4096 : (unsigned char*)F.out + (size_t)t * 4096);
#pragma unroll
        for (int c4 = 0; c4 < 4; ++c4) { const int lc = (c4 >> 1) * 128 + (c4 & 1) * 4;
            const f32x4 g4 = *(const f32x4*)(g + lc), b4 = *(const f32x4*)(b + lc);
            *(f32x4*)(od + cb + lc) = (f32x4){v[4 * c4], v[4 * c4 + 1], v[4 * c4 + 2], v[4 * c4 + 3]} * rstd * g4 + b4; }
    }
#undef P8_ROWS
}

struct Args { const float* in[25]; float* out; unsigned char* ws; int ph_lo, ph_hi; };
__global__ void __launch_bounds__(NTHREADS, 2) mk_fwd(Args args) {
    extern __shared__ __attribute__((aligned(16))) unsigned char lds_raw[];
    cg::grid_group grid = cg::this_grid();
    Frame F;
    F.lds = (LAS unsigned char*)lds_raw;
    F.MISC = (volatile LAS unsigned*)(F.lds + MISC_OFF);
    F.wave = __builtin_amdgcn_readfirstlane((int)threadIdx.x >> 6);
    F.G = gridDim.x; { const int bx = blockIdx.x; F.vcu = (F.G % 8 == 0) ? (bx % 8) * (F.G / 8) + bx / 8 : bx; }
    F.out = args.out; F.ws = args.ws; F.ctl = (unsigned*)(args.ws + WS_CTL);
    for (int u = F.wave * 64 + lane_id(); u < (LDS_BYTES - RING_BYTES) / 4; u += NTHREADS) ((LAS unsigned*)(F.lds + RING_BYTES))[u] = 0u;
    __syncthreads();
    if (F.wave == 0 && lane_id() == 0) {
#pragma unroll
        for (int i = 0; i < 25; ++i) { const unsigned long long p = (unsigned long long)args.in[i]; F.MISC[32 + 2 * i] = (unsigned)p; F.MISC[33 + 2 * i] = (unsigned)(p >> 32); }
    }
    __syncthreads();
    XcdBarrier bar = xcd_barrier_post(F.ctl + CW_BAR, F.MISC + 8, F.wave);
    const int lo = args.ph_lo, hi = args.ph_hi;
#define IN(k) (lo <= (k) && (k) < hi)
#define BOTH(k) (IN(k) && IN((k) + 1))
#define REP(k) for (int rep_ = 0; rep_ <= ((MK_DUP >> (k)) & 1); ++rep_)
    if (IN(0)) { REP(0) p0_prologue(F); if (BOTH(0)) { xcd_barrier(bar); if constexpr ((MK_DUP >> 17) & 1) xcd_barrier(bar); } }
    if (args.ph_lo < 0) grid.sync();
    if (IN(1)) {
        REP(1) {
        { pg8::StaticOrder S; S.init(M_TOK, 2048, D_MODEL, F.ws + WS_WIN, F.G, (int)blockIdx.x); S.skip_lo = 4; S.skip_n = 2;
          EpiP1 E{(bf16_t*)(F.ws + WS_QIMG), (bf16_t*)(F.ws + WS_KIMG), (bf16_t*)(F.ws + WS_HC), (const float*)(F.ws + WS_ROPE), 0};
          if constexpr ((MK_DUP >> 22) & 1) { EpiP1 Ed = E; Ed.dry = 1; pg8::gemm_phase<EpiP1, pg8::StaticOrder, true, false>(F.lds, F.wave, F.ws + WS_XB, D_MODEL * 2, D_MODEL, S, Ed); }
          if constexpr ((MK_DUP >> 23) & 1) { pg8::gemm_phase<EpiP1, pg8::StaticOrder, true, false>(F.lds, F.wave, F.ws + WS_XB, D_MODEL * 2, D_MODEL, S, E); }
          pg8::gemm_phase<EpiP1, pg8::StaticOrder, true, false>(F.lds, F.wave, F.ws + WS_XB, D_MODEL * 2, D_MODEL, S, E); }
        { pg8::StaticOrder S; S.init(M_TOK, 512, D_MODEL, F.ws + WS_WIN, F.G, (int)((blockIdx.x + 128) % gridDim.x)); S.skip_lo = 0; S.skip_n = 4;
          EpiP1V E{(bf16_t*)(F.ws + WS_VIMG)};
          pg8::gemm_phase<EpiP1V, pg8::StaticOrder, true, true>(F.lds, F.wave, F.ws + WS_XB, D_MODEL * 2, D_MODEL, S, E); }
        if (F.G == 256 && blockIdx.x < 128)
            p0_transpose_range(F, P0_NITEMS - P0_TAIL_ITEMS, P0_NITEMS, (int)blockIdx.x * NWAVES + F.wave, 128 * NWAVES);
        }
        if (BOTH(1)) { xcd_barrier(bar); if constexpr ((MK_DUP >> 17) & 1) xcd_barrier(bar); }
    }
    if (IN(2)) { REP(2) p2_phase(F); if (BOTH(2)) { xcd_barrier(bar); if constexpr ((MK_DUP >> 17) & 1) xcd_barrier(bar); } }
    if (IN(3)) {
        pg8::StaticOrder S; S.init(M_TOK, D_MODEL, D_MODEL, F.ws + WS_WOUT, F.G, (int)blockIdx.x);
        EpiP3 E{in_ptr(F, 0), (bf16_t*)(F.ws + WS_Y1), (float*)(F.ws + WS_YST)};
        REP(3) pg8::gemm_phase<EpiP3, pg8::StaticOrder, true, false>(F.lds, F.wave, F.ws + WS_MIXIN, D_MODEL * 2, D_MODEL, S, E);
        if (BOTH(3)) { xcd_barrier(bar); if constexpr ((MK_DUP >> 17) & 1) xcd_barrier(bar); }
    }
    if (IN(4)) { if constexpr ((MK_DUP >> 4) & 1) p4_phase(F, true); p4_phase(F, false); if (BOTH(4)) { xcd_barrier(bar); if constexpr ((MK_DUP >> 17) & 1) xcd_barrier(bar); } }
    if (IN(5)) {
        moe_build_tab(F);
        MoeSched<false> S; S.init(F); EpiP6 E{(bf16_t*)(F.ws + WS_H), 0};
        if constexpr ((MK_DUP >> 24) & 1) { EpiP6 Ed = E; Ed.dry = 1; pg8::gemm_phase<EpiP6, MoeSched<false>, true, false>(F.lds, F.wave, F.out, 4096, D_MODEL, S, Ed); }
        REP(5) pg8::gemm_phase<EpiP6, MoeSched<false>, true, false>(F.lds, F.wave, F.out, 4096, D_MODEL, S, E);
        if (BOTH(5)) { xcd_barrier(bar); if constexpr ((MK_DUP >> 17) & 1) xcd_barrier(bar); }
    }
    if (IN(6)) {
        if (!IN(5)) moe_build_tab(F);
        MoeSched<true> S; S.init(F); EpiP7 E{(unsigned char*)(F.ws + WS_YH), (unsigned char*)(F.ws + WS_SH), 0};
        if constexpr ((MK_DUP >> 20) & 1) { EpiP7 Ed{(unsigned char*)(F.ws + WS_YH), (unsigned char*)(F.ws + WS_SH), 1}; pg8::gemm_phase<EpiP7, MoeSched<true>, true, false>(F.lds, F.wave, F.ws + WS_H, 512, D_EXP, S, Ed); }
        REP(6) pg8::gemm_phase<EpiP7, MoeSched<true>, true, false>(F.lds, F.wave, F.ws + WS_H, 512, D_EXP, S, E);
        if (BOTH(6)) { xcd_barrier(bar); if constexpr ((MK_DUP >> 17) & 1) xcd_barrier(bar); }
    }
    if (IN(7)) { if (!IN(5) && !IN(6)) moe_build_tab(F); if constexpr ((MK_DUP >> 7) & 1) p8_combine(F, true); p8_combine(F, false); }
#ifdef MK_PHASES_EXTRA
    MK_PHASES_EXTRA
#endif
#undef IN
#undef BOTH
}

static int mk_grid(const void* fn) {
    static int grid = 0;
    if (!grid) { int dev = 0, cus = 0, per_cu = 0; (void)hipGetDevice(&dev); (void)hipDeviceGetAttribute(&cus, hipDeviceAttributeMultiprocessorCount, dev);
        (void)hipFuncSetAttribute(fn, hipFuncAttributeMaxDynamicSharedMemorySize, LDS_BYTES);
        (void)hipOccupancyMaxActiveBlocksPerMultiprocessor(&per_cu, fn, NTHREADS, LDS_BYTES);
        if (per_cu < 1) fprintf(stderr, "mk: occupancy query says %d blocks/CU\n", per_cu);
        grid = cus; }
    return grid;
}
static void mk_launch(void* const* d_in, void* d_out, void* d_ws, hipStream_t stream, int lo, int hi) {
    const int grid = mk_grid((const void*)mk_fwd);
    Args a; memset(&a, 0, sizeof(a));
    for (int i = 0; i < 25; ++i) a.in[i] = (const float*)d_in[i];
    a.out = (float*)d_out; a.ws = (unsigned char*)d_ws; a.ph_lo = lo; a.ph_hi = hi;
    void* args[] = {&a};
    (void)hipMemsetAsync((char*)d_ws + WS_CTL, 0, CTL_ZERO_BYTES, stream);
    hipError_t e = hipLaunchCooperativeKernel((const void*)mk_fwd, dim3(grid), dim3(NTHREADS), args, LDS_BYTES, stream);
    if (e != hipSuccess) fprintf(stderr, "cooperative launch failed: %s (grid %d)\n", hipGetErrorString(e), grid);
}
extern "C" void kernel_launch(void* const* d_in, const int* in_sizes, int n_in, void* d_out, int out_size, void* d_ws, size_t ws_size, hipStream_t stream) {
    if (ws_size < WS_END || n_in != 25 || out_size != M_TOK * D_MODEL) { fprintf(stderr, "kernel_launch: unexpected sizes (ws %zu, n_in %d, out %d)\n", ws_size, n_in, out_size); return; }
    mk_launch(d_in, d_out, d_ws, stream, 0, 8);
}
```

```cpp
#include <hip/hip_runtime.h>
#include <hip/hip_cooperative_groups.h>
#include <cstdio>
#include <cstdint>
#include <cstring>
namespace cg = cooperative_groups;
#ifndef MK_DUP
#define MK_DUP 0
#endif

#define LAS __attribute__((address_space(3)))
#define GAS __attribute__((address_space(1)))
typedef unsigned short bf16_t;
typedef short bf16x8 __attribute__((ext_vector_type(8)));
typedef float f32x4 __attribute__((ext_vector_type(4)));
typedef float f32x2 __attribute__((ext_vector_type(2)));
typedef float f32x16 __attribute__((ext_vector_type(16)));
typedef unsigned u32x4 __attribute__((ext_vector_type(4)));
typedef unsigned u32x2 __attribute__((ext_vector_type(2)));

constexpr int D_MODEL = 1024, BATCH = 4, SEQ = 4096, M_TOK = BATCH * SEQ;
constexpr int D_IN = 2560, N_HEADS = 4, HEAD_DIM = 128, SUB_DIM = 64, D_CONV = 512;
constexpr int CONV_W = 31, N_EXP = 64, TOP_K = 8, D_EXP = 256;
constexpr float LN_EPS = 1e-5f, ALPHA = 1.189207115002721f, ROUTED_SCALE = 2.5f, LAMBDA_INIT = 0.2f;
constexpr float QSCALE = 0.125f * 1.4426950408889634f;
constexpr int NWAVES = 8, NTHREADS = 512;

constexpr size_t MiB = 1u << 20;
constexpr size_t WS_CTL = 0, CTL_ZERO_BYTES = 64 * 1024;
constexpr size_t WS_ROPE = 1 * MiB;
constexpr size_t WS_SMALL = 2 * MiB;
constexpr size_t WS_WIN = 3 * MiB;
constexpr size_t WS_WOUT = 8 * MiB;
constexpr size_t WS_WR = 10 * MiB;
constexpr size_t WS_WSGU = 11 * MiB;
constexpr size_t WS_WSD = 12 * MiB;
constexpr size_t WS_WD = 13 * MiB;
constexpr size_t WS_WGU = 45 * MiB;
constexpr size_t WS_XB = 109 * MiB;
constexpr size_t WS_QIMG = 141 * MiB, WS_KIMG = 157 * MiB, WS_VIMG = 173 * MiB, WS_HC = 189 * MiB;
constexpr size_t WS_MIXIN = 205 * MiB;
constexpr size_t WS_Y1 = 109 * MiB;
constexpr size_t WS_YST = 141 * MiB;
constexpr size_t WS_YH = 45 * MiB;
constexpr size_t WS_H = 173 * MiB;
constexpr size_t WS_ROWPAIR = 246 * MiB;
constexpr size_t WS_GATE = 250 * MiB;
constexpr size_t WS_PAIRPOS = 250 * MiB + 512 * 1024;
constexpr size_t WS_SH = 251 * MiB;
constexpr size_t WS_END = 267 * MiB;
constexpr int CW_BAR = 1024;
constexpr int CW_ECNT = 8192;
constexpr int CW_TMO = 0;

typedef __bf16 bf16x2_t __attribute__((ext_vector_type(2)));
__device__ __forceinline__ unsigned cvt_pk_bf16(float lo, float hi) { f32x2 v = {lo, hi}; bf16x2_t b = __builtin_convertvector(v, bf16x2_t); return __builtin_bit_cast(unsigned, b); }
__device__ __forceinline__ float bf2f(unsigned short b) { return __uint_as_float((unsigned)b << 16); }
__device__ __forceinline__ float bflo(unsigned w) { return __uint_as_float(w << 16); }
__device__ __forceinline__ float bfhi(unsigned w) { return __uint_as_float(w & 0xffff0000u); }
__device__ __forceinline__ float wave_sum(float v) {
#pragma unroll
    for (int o = 1; o < 64; o <<= 1) v += __shfl_xor(v, o);
    return v;
}
__device__ __forceinline__ int lane_id() { int l; asm volatile("v_mbcnt_lo_u32_b32 %0, -1, 0\n\tv_mbcnt_hi_u32_b32 %0, -1, %0" : "=v"(l)); return l; }
__device__ __forceinline__ void store16_wt(void* p, u32x4 v) { asm volatile("global_store_dwordx4 %0, %1, off sc1\n\ts_nop 1" :: "v"(p), "v"(v) : "memory"); }
__device__ __forceinline__ float sigmoidf_(float x) { return __builtin_amdgcn_rcpf(1.f + __expf(-x)); }

#define XB_TMO      128
#define XB_XCNT(j)  (256  + 64 * (j))
#define XB_XSUB(j)  (1280 + 64 * (j))
#define XB_XGEN(j)  (2304 + 64 * (j))
#define XB_TOP      3328
#define XB_TOPGEN   3392
#define XCD_BAR_WORDS 3456
#define XB_SPIN_CAP (1u << 18)
__device__ __forceinline__ unsigned xb_ld(unsigned* p)              { return __hip_atomic_load(p, __ATOMIC_RELAXED, __HIP_MEMORY_SCOPE_AGENT); }
__device__ __forceinline__ unsigned xb_add(unsigned* p, unsigned v) { return __hip_atomic_fetch_add(p, v, __ATOMIC_RELAXED, __HIP_MEMORY_SCOPE_AGENT); }
__device__ __forceinline__ unsigned xb_xcc_id() { return (unsigned)__builtin_amdgcn_s_getreg((3 << 11) | 20) & 0xFu; }
#define XB_SPIN(cond, bar) do { unsigned _sp = 0; while (cond) { __builtin_amdgcn_s_sleep(1); \
    if ((++_sp & 255u) == 0u) { if (xb_ld(&(bar)[XB_TMO])) break; if (_sp > XB_SPIN_CAP) { atomicAdd(&(bar)[XB_TMO], 1u); break; } } } } while (0)
struct XcdBarrier { unsigned* bar; unsigned x; volatile LAS unsigned* st; int wave; };
__device__ __forceinline__ XcdBarrier xcd_barrier_post(unsigned* bar, volatile LAS unsigned* st, int wave) {
    XcdBarrier b; b.bar = bar; b.x = xb_xcc_id(); b.st = st; b.wave = wave;
    if (wave == 0 && lane_id() == 0) (void)xb_add(&bar[XB_XCNT(b.x)], 1u);
    return b;
}
__device__ __forceinline__ void xcd_barrier_complete(unsigned* bar, unsigned x, unsigned& nloc, unsigned& nx) {
    const unsigned G = gridDim.x * gridDim.y * gridDim.z;
    unsigned sum, cnt, mine, sp = 0u;
    for (;;) {
        sum = 0u; cnt = 0u; mine = 0u;
#pragma unroll
        for (unsigned j = 0; j < 16; ++j) { const unsigned c = xb_ld(&bar[XB_XCNT(j)]); sum += c; cnt += (c > 0u) ? 1u : 0u; mine = (j == x) ? c : mine; }
        if (sum == G) break;
        __builtin_amdgcn_s_sleep(1);
        if ((++sp & 255u) == 0u) { if (xb_ld(&bar[XB_TMO])) break; if (sp > XB_SPIN_CAP) { atomicAdd(&bar[XB_TMO], 1u); break; } }
    }
    nloc = mine > 0u ? mine : 1u; nx = cnt > 0u ? cnt : 1u;
}
__device__ __forceinline__ void xcd_barrier(const XcdBarrier& b) {
    asm volatile("s_waitcnt vmcnt(0)" ::: "memory");
    __syncthreads();
    if (b.wave == 0 && lane_id() == 0) {
        unsigned* bar = b.bar;
        __builtin_amdgcn_s_waitcnt(0);
        unsigned nloc = b.st[0], nx = b.st[1];
        if (nloc == 0u) { xcd_barrier_complete(bar, b.x, nloc, nx); b.st[0] = nloc; b.st[1] = nx; }
        const unsigned old = xb_add(&bar[XB_XSUB(b.x)], 1u);
        const unsigned gen = old / nloc;
        if (old + 1u == (gen + 1u) * nloc) {
            __builtin_amdgcn_fence(__ATOMIC_RELEASE, "agent");
            asm volatile("s_waitcnt vmcnt(0)" ::: "memory");
            const unsigned og = xb_add(&bar[XB_TOP], 1u);
            const unsigned tg = og / nx;
            if (og + 1u == (tg + 1u) * nx) xb_add(&bar[XB_TOPGEN], 1u);
            else XB_SPIN(xb_ld(&bar[XB_TOPGEN]) == tg, bar);
            __builtin_amdgcn_fence(__ATOMIC_ACQUIRE, "agent");
            xb_add(&bar[XB_XGEN(b.x)], 1u);
            asm volatile("s_waitcnt vmcnt(0)" ::: "memory");
        } else {
            XB_SPIN(xb_ld(&bar[XB_XGEN(b.x)]) == gen, bar);
            __builtin_amdgcn_fence(__ATOMIC_ACQUIRE, "agent");
            asm volatile("s_waitcnt vmcnt(0)" ::: "memory");
        }
    }
    __syncthreads();
}

namespace pg8 {
constexpr int BM = 256, BK = 64, HALF = 128, HTB = HALF * BK * 2, STAGE_BYTES = 8 * HTB, NXCD = 8, WGM = 2;
__host__ __device__ __forceinline__ int lds_byte(int r, int c) { const int st = (r >> 4) * 2 + (c >> 5), rr = r & 15, cc = c & 31, ob = rr * 64 + cc * 2; return st * 1024 + (ob ^ (((ob >> 9) & 1) << 5)); }
__host__ __device__ __forceinline__ void stage_rc(int b, int& R, int& C) { const int st = b / 1024, sb = b % 1024, swz = sb ^ (((sb >> 9) & 1) << 5); R = (st >> 1) * 16 + swz / 64; C = (st & 1) * 32 + (swz % 64) / 2; }
__host__ __device__ __forceinline__ int perm32(int rho) { const int n = rho >> 4, i = rho & 15; return 8 * (i >> 2) + 4 * n + (i & 3); }

struct Unit { int pm, pn, e, cnt, arow0; const char* Bp; };

struct StaticOrder {
    int nM, nN, nwg, G, c; const char* Bt; int Kb  ; int skip_lo, skip_n;
    __device__ void init(int M, int N, int K, const void* Bt_, int G_, int c_) { nM = M / BM; nN = N / BM; nwg = nM * nN; G = G_; c = c_; Bt = (const char*)Bt_; Kb = K * 2; skip_lo = 1 << 30; skip_n = 0; }
    __device__ bool next(int i, Unit& u) const {
        const long L = (long)i * G + c; if (L >= nwg) return false;
        int wgid = (int)L; { const int q = nwg / NXCD, r = nwg % NXCD, xcd = wgid % NXCD, off = wgid / NXCD; wgid = (xcd < r ? xcd * (q + 1) : r * (q + 1) + (xcd - r) * q) + off; }
        const int nig = WGM * nN, gid = wgid / nig, fm = gid * WGM, gsz = (nM - fm) < WGM ? (nM - fm) : WGM;
        u.pm = fm + ((wgid % nig) % gsz); u.pn = (wgid % nig) / gsz; if (u.pn >= skip_lo) u.pn += skip_n; u.e = 0; u.cnt = 256; u.arow0 = u.pm * BM;
        u.Bp = Bt + (size_t)u.pn * BM * Kb; return true;
    }
    __device__ __forceinline__ int arow(const Unit& u, int r) const { return u.arow0 + r; }
};

template <class Epi, class Sched, bool ALIGN_EPI, bool SWAP>
__device__ __forceinline__ void gemm_phase(LAS unsigned char* lds, const int wid, const void* Abase, const int lda_bytes, const int K, const Sched& S, const Epi& E) {
    const int lane = lane_id(), tid = wid * 64 + lane, wr = wid >> 2, wc = wid & 3, fr = lane & 15, fq = lane >> 4;
    const int nt = K / BK;
    int sR[2], sC[2]; unsigned voffB[2];
#pragma unroll
    for (int i = 0; i < 2; ++i) { int R, C; stage_rc(tid * 16 + i * 8192, R, C); const int Rb = Epi::PERM ? ((R & ~31) + perm32(R & 31)) : R;
        sR[i] = R; sC[i] = C * 2; voffB[i] = (unsigned)(Rb * K + C) * 2u; }
    const size_t kstep = (size_t)(BK * 2);
    const size_t hstepB = (size_t)HALF * K * 2;
    const unsigned ldsw = (unsigned)wid * 1024u;
    const int aoff = lds_byte(wr * 64 + fr, fq * 8), boff = lds_byte(wc * 32 + fr, fq * 8);
    const char* Ab = (const char*)Abase;
#define PG8_SA(b, h) (((b) * 2 + (h)) * HTB)
#define PG8_SB(b, h) ((4 + (b) * 2 + (h)) * HTB)
#define PG8_STAGE(bufoff, gbase, voff) do { _Pragma("unroll") for (int _i = 0; _i < 2; ++_i) \
        __builtin_amdgcn_global_load_lds((const unsigned*)((const char*)(gbase) + (voff)[_i]), (LAS unsigned*)(lds + (bufoff) + ldsw + _i * 8192), 16, 0, 0); } while (0)
#define PG8_LDA(dst, b, h) do { _Pragma("unroll") for (int m = 0; m < 4; ++m) _Pragma("unroll") for (int k = 0; k < 2; ++k) dst[m][k] = *(const LAS bf16x8*)(lds + PG8_SA(b, h) + aoff + m * 2048 + k * 1024); } while (0)
#define PG8_LDB(dst, b, h) do { _Pragma("unroll") for (int n = 0; n < 2; ++n) _Pragma("unroll") for (int k = 0; k < 2; ++k) dst[n][k] = *(const LAS bf16x8*)(lds + PG8_SB(b, h) + boff + n * 2048 + k * 1024); } while (0)
#define PG8_MMA(ai, bj, At, Bt) do { __builtin_amdgcn_s_setprio(1); \
        if constexpr (SWAP) { _Pragma("unroll") for (int m = 0; m < 4; ++m) _Pragma("unroll") for (int n = 0; n < 2; ++n) _Pragma("unroll") for (int k = 0; k < 2; ++k) \
            acc[ai][bj][m][n] = __builtin_amdgcn_mfma_f32_16x16x32_bf16(At[m][k], Bt[n][k], acc[ai][bj][m][n], 0, 0, 0); } \
        else { _Pragma("unroll") for (int m = 0; m < 4; ++m) _Pragma("unroll") for (int n = 0; n < 2; ++n) _Pragma("unroll") for (int k = 0; k < 2; ++k) \
            acc[ai][bj][m][n] = __builtin_amdgcn_mfma_f32_16x16x32_bf16(Bt[n][k], At[m][k], acc[ai][bj][m][n], 0, 0, 0); } \
        __builtin_amdgcn_s_setprio(0); } while (0)
#define PG8_WAIT_V(n) asm volatile("s_waitcnt vmcnt(" #n ")" ::: "memory")
#define PG8_WAIT_L(n) asm volatile("s_waitcnt lgkmcnt(" #n ")" ::: "memory")
#define PG8_BAR __builtin_amdgcn_s_barrier()
#define PG8_SCHED __builtin_amdgcn_sched_barrier(0)
#define PG8_AOFF(dst, u) do { _Pragma("unroll") for (int _h = 0; _h < 2; ++_h) _Pragma("unroll") for (int _i = 0; _i < 2; ++_i) \
        dst[_h][_i] = (unsigned)S.arow(u, _h * HALF + sR[_i]) * (unsigned)lda_bytes + (unsigned)sC[_i]; } while (0)
    Unit cur, nxt; int ui = 0;
    if (!S.next(0, cur)) return;
    f32x4 acc[2][2][4][2];
#pragma unroll
    for (int a = 0; a < 2; ++a)
#pragma unroll
        for (int b = 0; b < 2; ++b)
#pragma unroll
            for (int m = 0; m < 4; ++m)
#pragma unroll
                for (int n = 0; n < 2; ++n) acc[a][b][m][n] = (f32x4){0.f, 0.f, 0.f, 0.f};
    bf16x8 At[4][2], B0[2][2], B1[2][2];
    unsigned aoC[2][2];
    PG8_AOFF(aoC, cur);
    const char* cB = cur.Bp;
    PG8_STAGE(PG8_SB(0, 0), cB, voffB); PG8_STAGE(PG8_SB(0, 1), cB + hstepB, voffB); PG8_STAGE(PG8_SA(0, 0), Ab, aoC[0]); PG8_STAGE(PG8_SA(0, 1), Ab, aoC[1]);
    if (wr == 1) PG8_BAR;
    PG8_WAIT_V(2); PG8_BAR;
    PG8_STAGE(PG8_SB(1, 0), cB + kstep, voffB); PG8_STAGE(PG8_SA(1, 0), Ab + kstep, aoC[0]); PG8_STAGE(PG8_SB(1, 1), cB + hstepB + kstep, voffB);
    PG8_WAIT_V(6); PG8_BAR;
    for (;;) {
        const bool has_next = S.next(ui + 1, nxt);
        unsigned aoN[2][2];
        if (has_next) { PG8_AOFF(aoN, nxt); } else {
#pragma unroll
            for (int h = 0; h < 2; ++h)
#pragma unroll
                for (int i = 0; i < 2; ++i) aoN[h][i] = aoC[h][i]; }
        const char* nB = has_next ? nxt.Bp : cB;
_Pragma("unroll 1")
        for (int t = 0; t < nt; t += 2) {
            const bool last = (t == nt - 2);
            const char* a1 = Ab + (size_t)(t + 1) * kstep;
            const char* a2 = last ? Ab : Ab + (size_t)(t + 2) * kstep; const char* b2 = last ? nB : cB + (size_t)(t + 2) * kstep;
            const char* a3 = a2 + kstep; const char* b3 = b2 + kstep;
            PG8_LDB(B0, 0, 0); PG8_LDB(B1, 0, 1); PG8_SCHED; PG8_LDA(At, 0, 0); PG8_STAGE(PG8_SA(1, 1), a1, aoC[1]);
            { const unsigned msk = last ? 0xffffffffu : 0u;
              _Pragma("unroll") for (int h = 0; h < 2; ++h)
                _Pragma("unroll") for (int i = 0; i < 2; ++i) aoC[h][i] = (aoN[h][i] & msk) | (aoC[h][i] & ~msk); }
            PG8_WAIT_V(8); PG8_WAIT_L(0); PG8_BAR; PG8_MMA(0, 0, At, B0); PG8_MMA(0, 1, At, B1); PG8_BAR; PG8_SCHED;
            PG8_LDA(At, 0, 1); PG8_STAGE(PG8_SB(0, 0), b2, voffB); PG8_STAGE(PG8_SB(0, 1), b2 + hstepB, voffB); PG8_STAGE(PG8_SA(0, 0), a2, aoC[0]);
            PG8_WAIT_V(8); PG8_WAIT_L(0); PG8_BAR; PG8_MMA(1, 0, At, B0); PG8_MMA(1, 1, At, B1); PG8_BAR; PG8_SCHED;
            PG8_LDB(B0, 1, 0); PG8_LDB(B1, 1, 1); PG8_SCHED; PG8_LDA(At, 1, 0); PG8_STAGE(PG8_SA(0, 1), a2, aoC[1]);
            PG8_WAIT_V(8); PG8_WAIT_L(0); PG8_BAR; PG8_MMA(0, 0, At, B0); PG8_MMA(0, 1, At, B1); PG8_BAR; PG8_SCHED;
            PG8_LDA(At, 1, 1); PG8_STAGE(PG8_SB(1, 0), b3, voffB); PG8_STAGE(PG8_SB(1, 1), b3 + hstepB, voffB); PG8_STAGE(PG8_SA(1, 0), a3, aoC[0]);
            PG8_WAIT_V(8); PG8_WAIT_L(0); PG8_BAR; PG8_MMA(1, 0, At, B0); PG8_MMA(1, 1, At, B1); PG8_BAR; PG8_SCHED;
        }
        if constexpr (ALIGN_EPI) { if (wr == 0) PG8_BAR; }
        E(acc, cur, wr, wc, fr, fq);
        if (!has_next) break;
#pragma unroll
        for (int a = 0; a < 2; ++a)
#pragma unroll
            for (int b = 0; b < 2; ++b)
#pragma unroll
                for (int m = 0; m < 4; ++m)
#pragma unroll
                    for (int n = 0; n < 2; ++n) acc[a][b][m][n] = (f32x4){0.f, 0.f, 0.f, 0.f};
        cur = nxt; cB = nB; ++ui;
        if constexpr (ALIGN_EPI) { if (wr == 1) PG8_BAR; }
    }
    PG8_WAIT_V(0);
    if constexpr (!ALIGN_EPI) { if (wr == 0) PG8_BAR; }
    PG8_BAR;
#undef PG8_SA
#undef PG8_SB
#undef PG8_STAGE
#undef PG8_LDA
#undef PG8_LDB
#undef PG8_MMA
#undef PG8_WAIT_V
#undef PG8_WAIT_L
#undef PG8_BAR
#undef PG8_SCHED
#undef PG8_AOFF
}
}

constexpr int RING_BYTES = 131072, MISC_OFF = RING_BYTES + 320, LDS_BYTES = 147456;
struct Frame {
    LAS unsigned char* lds; volatile LAS unsigned* MISC; unsigned* ctl;
    int wave, vcu, G;
    float* out; unsigned char* ws;
};
__device__ __forceinline__ const float* in_ptr(const Frame& F, int i) {
    const unsigned lo = __builtin_amdgcn_readfirstlane(F.MISC[32 + 2 * i]), hi = __builtin_amdgcn_readfirstlane(F.MISC[33 + 2 * i]);
    return (const float*)(((unsigned long long)hi << 32) | (unsigned long long)lo);
}

struct P0Item { const float* src; bf16_t* dst; int N, K; float scale; };
__device__ __forceinline__ int map_win(int n0) { if (n0 < 1536) return n0; const int j = n0 - 1536, gate = j >> 9, ch = j & 511; return 1536 + (ch >> 7) * 256 + gate * 128 + (ch & 127); }
__device__ __forceinline__ int map_gu(int n0, int up) { return (n0 >> 7) * 256 + up * 128 + (n0 & 127); }
__device__ __forceinline__ P0Item p0_decode(const Frame& F, int it) {
    constexpr int I_WIN = 16 * 80, I_WOUT = 16 * 32, I_WR = 16 * 2, I_E = 128;
    unsigned char* ws = F.ws; P0Item r; r.scale = 1.f; int q = it;
    if (q < I_WIN) { const int kb = q / 80, nb = q % 80; r.N = 2560; r.K = 1024; r.src = in_ptr(F, 2) + (size_t)kb * 64 * 2560 + nb * 32; r.dst = (bf16_t*)(ws + WS_WIN) + (size_t)map_win(nb * 32) * 1024 + kb * 64; return r; } q -= I_WIN;
    if (q < I_WOUT) { const int kb = q / 32, nb = q % 32; r.N = 1024; r.K = 1024; r.src = in_ptr(F, 12) + (size_t)kb * 64 * 1024 + nb * 32; r.dst = (bf16_t*)(ws + WS_WOUT) + (size_t)(nb * 32) * 1024 + kb * 64; return r; } q -= I_WOUT;
    if (q < I_WR) { const int kb = q / 2, nb = q % 2; r.N = 64; r.K = 1024; r.src = in_ptr(F, 15) + (size_t)kb * 64 * 64 + nb * 32; r.dst = (bf16_t*)(ws + WS_WR) + (size_t)(nb * 32) * 1024 + kb * 64; return r; } q -= I_WR;
    const int e = q / (3 * I_E) - 1, w = (q / I_E) % 3, qq = q % I_E;
    if (w < 2) { const int kb = qq / 8, nb = qq % 8; r.N = 256; r.K = 1024;
        const float* base = e < 0 ? (w ? in_ptr(F, 21) : in_ptr(F, 20)) : (w ? in_ptr(F, 18) : in_ptr(F, 17)) + (size_t)e * 1024 * 256;
        bf16_t* db = e < 0 ? (bf16_t*)(ws + WS_WSGU) : (bf16_t*)(ws + WS_WGU) + (size_t)e * 512 * 1024;
        r.src = base + (size_t)kb * 64 * 256 + nb * 32; r.dst = db + (size_t)map_gu(nb * 32, w) * 1024 + kb * 64; }
    else { const int kb = qq / 32, nb = qq % 32; r.N = 1024; r.K = 256; r.scale = 16.f;
        const float* base = e < 0 ? in_ptr(F, 22) : in_ptr(F, 19) + (size_t)e * 256 * 1024;
        bf16_t* db = e < 0 ? (bf16_t*)(ws + WS_WSD) : (bf16_t*)(ws + WS_WD) + (size_t)e * 1024 * 256;
        r.src = base + (size_t)kb * 64 * 1024 + nb * 32; r.dst = db + (size_t)(nb * 32) * 256 + kb * 64; }
    return r;
}
constexpr int P0_NITEMS = 16 * 80 + 16 * 32 + 16 * 2 + 65 * 3 * 128;
constexpr int P0_TAIL_ITEMS = 128 * NWAVES * 6;
__device__ __forceinline__ void p0_transpose_range(Frame& F, const int lo, const int hi, const int gw, const int NGW) {
    LAS float* scr = (LAS float*)(F.lds + F.wave * 16384);
    const int lane = lane_id();
    constexpr int NITEMS = P0_NITEMS;
    {
        float cv[32], nv[32];
        int it = lo + gw;
        P0Item cur = p0_decode(F, it < hi ? it : 0);
        if (it < hi) {
#pragma unroll
            for (int i = 0; i < 32; ++i) cv[i] = __builtin_nontemporal_load(cur.src + (size_t)(2 * i + (lane >> 5)) * cur.N + (lane & 31));
        }
        for (; it < hi; it += NGW) {
            const int nit = it + NGW; const bool hn = nit < hi;
            const P0Item nx = p0_decode(F, hn ? nit : 0);
            if (hn) {
#pragma unroll
                for (int i = 0; i < 32; ++i) nv[i] = __builtin_nontemporal_load(nx.src + (size_t)(2 * i + (lane >> 5)) * nx.N + (lane & 31));
            }
#pragma unroll
            for (int i = 0; i < 32; ++i) scr[(2 * i + (lane >> 5)) * 33 + (lane & 31)] = cv[i];
            asm volatile("s_waitcnt lgkmcnt(0)" ::: "memory");
            const int c = lane & 7;
#pragma unroll
            for (int j = 0; j < 4; ++j) { const int n = (lane >> 3) + 8 * j; const LAS float* s = scr + (8 * c) * 33 + n;
                const float sc = cur.scale;
                u32x4 o; o.x = cvt_pk_bf16(s[0 * 33] * sc, s[1 * 33] * sc); o.y = cvt_pk_bf16(s[2 * 33] * sc, s[3 * 33] * sc); o.z = cvt_pk_bf16(s[4 * 33] * sc, s[5 * 33] * sc); o.w = cvt_pk_bf16(s[6 * 33] * sc, s[7 * 33] * sc);
                __builtin_nontemporal_store(o, (u32x4*)(cur.dst + (size_t)n * cur.K + 8 * c)); }
            asm volatile("s_waitcnt lgkmcnt(0)" ::: "memory");
            cur = nx;
#pragma unroll
            for (int i = 0; i < 32; ++i) cv[i] = nv[i];
        }
    }
    (void)NITEMS;
}
__device__ __forceinline__ void p0_prologue(Frame& F) {
    const int gw = F.vcu * NWAVES + F.wave, NGW = F.G * NWAVES, lane = lane_id();
    unsigned char* ws = F.ws;
    float lq1 = 0.f, lk1 = 0.f, lq2 = 0.f, lk2 = 0.f;
    if (gw == 0) { lq1 = ((const GAS float*)in_ptr(F, 3))[lane]; lk1 = ((const GAS float*)in_ptr(F, 4))[lane]; lq2 = ((const GAS float*)in_ptr(F, 5))[lane]; lk2 = ((const GAS float*)in_ptr(F, 6))[lane]; }
    p0_transpose_range(F, 0, 16 * 80 + 16 * 32 + 16 * 2 + 3 * 128, F.wave * F.G + F.vcu, NGW);
    { const int gt = F.vcu * NTHREADS + F.wave * 64 + lane, NGT = F.G * NTHREADS; const f32x4* x4 = (const f32x4*)in_ptr(F, 0); u32x4* xb = (u32x4*)(ws + WS_XB);
      for (int i = gt; i < M_TOK * D_MODEL / 8; i += NGT) { const f32x4 a = x4[2 * i], b = x4[2 * i + 1];
          u32x4 o; o.x = cvt_pk_bf16(a[0], a[1]); o.y = cvt_pk_bf16(a[2], a[3]); o.z = cvt_pk_bf16(b[0], b[1]); o.w = cvt_pk_bf16(b[2], b[3]); xb[i] = o; }
      const int* pos = (const int*)in_ptr(F, 1); float* rope = (float*)(ws + WS_ROPE);
      for (int i = gt; i < M_TOK * 8; i += NGT) { const int t = i >> 3, k = i & 7; const float inv = powf(500000.0f, -(float)(2 * k) / 16.0f); const float ang = (float)pos[t] * inv;
          rope[t * 16 + k] = cosf(ang); rope[t * 16 + 8 + k] = sinf(ang); }
      if (gw == 0) { const float a = wave_sum(lq1 * lk1), b = wave_sum(lq2 * lk2); if (lane == 0) ((float*)(ws + WS_SMALL))[0] = expf(a) - expf(b) + LAMBDA_INIT; }
    }
}

struct EpiP1 {
    static constexpr bool PERM = true;
    bf16_t *Qimg, *Kimg, *Hc; const float* rope; int dry;
    __device__ __forceinline__ void operator()(const f32x4 (&acc)[2][2][4][2], const pg8::Unit& u, int wr, int wc, int fr_in, int fq_in) const {
        int fr = fr_in, fq = fq_in; asm volatile("" : "+v"(fr), "+v"(fq));
        if (dry) { _Pragma("unroll") for (int ai = 0; ai < 2; ++ai) _Pragma("unroll") for (int bj = 0; bj < 2; ++bj) _Pragma("unroll") for (int m = 0; m < 4; ++m) asm volatile("" :: "v"(acc[ai][bj][m][0]), "v"(acc[ai][bj][m][1])); return; }
        const int pn = u.pn;
        if (pn < 4) {
            bf16_t* img = pn < 2 ? Qimg : Kimg; const float sc = pn < 2 ? QSCALE : 1.f; const bool roped = (wc & 1) == 0;
#pragma unroll
            for (int ai = 0; ai < 2; ++ai)
#pragma unroll
                for (int m = 0; m < 4; ++m) {
                    const int row = u.pm * 256 + ai * 128 + wr * 64 + m * 16 + fr, b = row >> 12, sp = row & 4095;
                    f32x4 c0, c1, s0, s1;
                    if (roped) { const f32x4* rp = (const f32x4*)(rope + (size_t)row * 16); c0 = rp[0]; c1 = rp[1]; s0 = rp[2]; s1 = rp[3]; }
#pragma unroll
                    for (int bj = 0; bj < 2; ++bj) {
                        const int cc = (pn & 1) * 256 + bj * 128 + wc * 32 + fq * 8, h = cc >> 7, c2 = (cc >> 6) & 1, d0 = cc & 63;
                        f32x4 v0 = acc[ai][bj][m][0], v1 = acc[ai][bj][m][1];
                        if (roped) {
                            f32x4 p0, p1;
#pragma unroll
                            for (int j = 0; j < 4; ++j) { p0[j] = __shfl_xor(v0[j], 16); p1[j] = __shfl_xor(v1[j], 16); }
                            if (fq == 0) { v0 = v0 * c0 - p0 * s0; v1 = v1 * c1 - p1 * s1; }
                            else if (fq == 1) { v0 = v0 * c0 + p0 * s0; v1 = v1 * c1 + p1 * s1; }
                        }
                        v0 = v0 * sc; v1 = v1 * sc;
                        u32x4 w; w.x = cvt_pk_bf16(v0[0], v0[1]); w.y = cvt_pk_bf16(v0[2], v0[3]); w.z = cvt_pk_bf16(v1[0], v1[1]); w.w = cvt_pk_bf16(v1[2], v1[3]);
                        const size_t off = (size_t)((b * 4 + h) * 2 + c2) * (4096 * 64) + (size_t)(sp >> 5) * 2048 + (d0 >> 4) * 512 + ((d0 >> 3) & 1) * 256 + (sp & 31) * 8;
                        *(u32x4*)(img + off) = w;
                    }
                }
        } else {
#pragma unroll
            for (int ai = 0; ai < 2; ++ai)
#pragma unroll
                for (int m = 0; m < 4; ++m) {
                    const int row = u.pm * 256 + ai * 128 + wr * 64 + m * 16 + fr; const int ch0 = (pn - 6) * 128 + wc * 32 + fq * 8;
                    f32x4 h0, h1;
#pragma unroll
                    for (int j = 0; j < 4; ++j) { h0[j] = acc[ai][0][m][0][j] * sigmoidf_(acc[ai][1][m][0][j]); h1[j] = acc[ai][0][m][1][j] * sigmoidf_(acc[ai][1][m][1][j]); }
                    u32x4 w; w.x = cvt_pk_bf16(h0[0], h0[1]); w.y = cvt_pk_bf16(h0[2], h0[3]); w.z = cvt_pk_bf16(h1[0], h1[1]); w.w = cvt_pk_bf16(h1[2], h1[3]);
                    *(u32x4*)(Hc + (size_t)row * 512 + ch0) = w;
                }
        }
    }
};

struct EpiP1V {
    static constexpr bool PERM = true;
    bf16_t* Vimg;
    __device__ __forceinline__ void operator()(const f32x4 (&acc)[2][2][4][2], const pg8::Unit& u, int wr, int wc, int fr_in, int fq_in) const {
        int fr = fr_in, fq = fq_in; asm volatile("" : "+v"(fr), "+v"(fq));
        const int pn = u.pn;
        {
#pragma unroll
            for (int ai = 0; ai < 2; ++ai)
#pragma unroll
                for (int m = 0; m < 4; ++m) {
                    const int tok = u.pm * 256 + ai * 128 + wr * 64 + m * 16 + fq * 4, b = tok >> 12, sp = tok & 4095;
#pragma unroll
                    for (int bj = 0; bj < 2; ++bj)
#pragma unroll
                        for (int n = 0; n < 2; ++n) {
                            const int col = (pn - 4) * 256 + bj * 128 + wc * 32 + 8 * (fr >> 2) + 4 * n + (fr & 3), h = col >> 7, dv = col & 127;
                            const f32x4 v = acc[ai][bj][m][n];
                            u32x2 w; w.x = cvt_pk_bf16(v[0], v[1]); w.y = cvt_pk_bf16(v[2], v[3]);
                            const size_t off = (size_t)(b * 4 + h) * (4096 * 128) + (size_t)(sp >> 6) * 8192 + ((sp >> 4) & 3) * 2048 + (dv >> 5) * 512 + ((sp >> 2) & 1) * 256 + (dv & 31) * 8 + ((sp >> 3) & 1) * 4;
                            *(u32x2*)(Vimg + off) = w;
                        }
                }
        }
    }
};

__device__ __forceinline__ float exp2_(float x) { return __builtin_amdgcn_exp2f(x); }
__device__ __forceinline__ void glds16(const void* gsrc, unsigned lds_dst) { unsigned keep;
    asm volatile("s_mov_b32 %0, m0\n\ts_mov_b32 m0, %2\n\ts_nop 0\n\tglobal_load_lds_dwordx4 %1, off\n\ts_mov_b32 m0, %0" : "=&s"(keep) : "v"(gsrc), "s"(lds_dst) : "memory"); }
__device__ __forceinline__ void glds16_nt(const void* gsrc, unsigned lds_dst) { unsigned keep;
    asm volatile("s_mov_b32 %0, m0\n\ts_mov_b32 m0, %2\n\ts_nop 0\n\tglobal_load_lds_dwordx4 %1, off nt\n\ts_mov_b32 m0, %0" : "=&s"(keep) : "v"(gsrc), "s"(lds_dst) : "memory"); }
constexpr int W2_LO = 16 * 80 + 16 * 32 + 16 * 2 + 3 * 128;
constexpr int W2_LDS = 98304;
struct WHalf { const float* src; bf16_t* dst; int N, K; float scale; };
__device__ __forceinline__ int w2_hi(const Frame& F) { return P0_NITEMS - (F.G == 256 ? P0_TAIL_ITEMS : 0); }
__device__ __forceinline__ bool w2_decode(const Frame& F, const int ord, WHalf& h) {
    const int it = W2_LO + F.vcu * NWAVES + F.wave + (ord >> 1) * (F.G * NWAVES);
    if (it >= w2_hi(F)) return false;
    const int q = it - W2_LO, e = q / 384, r = q - e * 384, w = r >> 7, qq = r & 127, k0 = 32 * (ord & 1);
    const bool dn = w == 2;
    const int kb = dn ? qq >> 5 : qq >> 3, nb = dn ? qq & 31 : qq & 7;
    h.N = dn ? 1024 : 256; h.K = dn ? 256 : 1024; h.scale = dn ? 16.f : 1.f;
    h.src = in_ptr(F, 17 + w) + (size_t)e * 262144 + (size_t)((kb * 64 + k0) * h.N + nb * 32);
    h.dst = (bf16_t*)(F.ws + (dn ? WS_WD : WS_WGU)) + (size_t)e * (dn ? 262144 : 524288) + (size_t)((dn ? nb * 32 : map_gu(nb * 32, w)) * h.K + kb * 64 + k0);
    return true;
}
__device__ __forceinline__ void w2_dma(const WHalf& h, const unsigned ldsbuf) {
    const int lane = lane_id();
#pragma unroll
    for (int q = 0; q < 4; ++q) { const int rho = 8 * q + (lane >> 3), k = rho ^ ((rho >> 4) & 1);
        glds16_nt(h.src + (size_t)k * h.N + 4 * (lane & 7), (unsigned)__builtin_amdgcn_readfirstlane((int)(ldsbuf + q * 1024))); }
}
__device__ __forceinline__ void w2_proc(const WHalf& h, const LAS unsigned char* buf) {
    const int lane = lane_id(), n = lane & 31, hh = lane >> 5;
    const LAS float* be = (const LAS float*)(buf + n * 4 + hh * 2048 + hh * 128);
    const LAS float* bo = (const LAS float*)(buf + n * 4 + hh * 2048 - hh * 128);
    float v[16];
#pragma unroll
    for (int t = 0; t < 16; ++t) v[t] = ((t & 1) ? bo : be)[t * 32];
    const float sc = h.scale;
    u32x4 o0, o1;
    o0.x = cvt_pk_bf16(v[0] * sc, v[1] * sc); o0.y = cvt_pk_bf16(v[2] * sc, v[3] * sc); o0.z = cvt_pk_bf16(v[4] * sc, v[5] * sc); o0.w = cvt_pk_bf16(v[6] * sc, v[7] * sc);
    o1.x = cvt_pk_bf16(v[8] * sc, v[9] * sc); o1.y = cvt_pk_bf16(v[10] * sc, v[11] * sc); o1.z = cvt_pk_bf16(v[12] * sc, v[13] * sc); o1.w = cvt_pk_bf16(v[14] * sc, v[15] * sc);
    bf16_t* d = h.dst + (size_t)n * h.K + 16 * hh;
    __builtin_nontemporal_store(o0, (u32x4*)d); __builtin_nontemporal_store(o1, (u32x4*)(d + 8));
}
constexpr int ATT_SUBG_LDS = 135168;
__device__ __forceinline__ void attn_unit(Frame& F, const int bh, const int qb, const float lam, int& wk) {
    const int lane = lane_id(), wave = F.wave, tid = wave * 64 + lane, sub = wave >> 2, wq = wave & 3, hi = lane >> 5;
    const bf16_t* Kg0 = (const bf16_t*)(F.ws + WS_KIMG) + (size_t)(bh * 2) * 262144 + tid * 8;
    const bf16_t* Kg1 = Kg0 + 262144;
    const bf16_t* Vg = (const bf16_t*)(F.ws + WS_VIMG) + (size_t)bh * 524288 + tid * 8;
    const bf16_t* Qg = (const bf16_t*)(F.ws + WS_QIMG) + (size_t)(bh * 2 + sub) * 262144 + (size_t)(qb * 4 + wq) * 2048 + lane * 8;
    LAS unsigned char* lds = F.lds;
    bf16x8 q[4];
#pragma unroll
    for (int s = 0; s < 4; ++s) q[s] = *(const bf16x8*)(Qg + s * 512);
    const int nt = 2 * qb + 2, cq = 2 * qb + (wq >> 1);
    const unsigned lds0 = (unsigned)(unsigned long)lds;
#define ATT_DMA(j, SO) do { const unsigned _d = lds0 + (unsigned)(SO) + (unsigned)wave * 1024u; \
        glds16(Kg0 + (size_t)(j) * 4096, (unsigned)__builtin_amdgcn_readfirstlane((int)_d)); \
        glds16(Kg1 + (size_t)(j) * 4096, (unsigned)__builtin_amdgcn_readfirstlane((int)(_d + 8192u))); \
        glds16(Vg + (size_t)(j) * 8192, (unsigned)__builtin_amdgcn_readfirstlane((int)(_d + 16384u))); \
        glds16(Vg + (size_t)(j) * 8192 + 4096, (unsigned)__builtin_amdgcn_readfirstlane((int)(_d + 24576u))); } while (0)
#define ATT_BAR() do { asm volatile("s_waitcnt vmcnt(0) lgkmcnt(0)" ::: "memory"); __builtin_amdgcn_s_barrier(); asm volatile("" ::: "memory"); } while (0)
#define ATT_BAR4() do { asm volatile("s_waitcnt vmcnt(4) lgkmcnt(0)" ::: "memory"); __builtin_amdgcn_s_barrier(); asm volatile("" ::: "memory"); } while (0)
#define ATT_BARN(N) do { asm volatile("s_waitcnt vmcnt(" #N ") lgkmcnt(0)" ::: "memory"); __builtin_amdgcn_s_barrier(); asm volatile("" ::: "memory"); } while (0)
    asm volatile("s_waitcnt vmcnt(0)" : "+v"(q[0]), "+v"(q[1]), "+v"(q[2]), "+v"(q[3]));
    ATT_DMA(0, 0); ATT_DMA(1, 32768);
    ATT_BAR4();
    f32x16 o[4];
#pragma unroll
    for (int d = 0; d < 4; ++d)
#pragma unroll
        for (int r = 0; r < 16; ++r) o[d][r] = 0.f;
    float m = 0.f, l = 0.f;
    f32x16 negm;
#pragma unroll
    for (int r = 0; r < 16; ++r) negm[r] = 0.f;
    int so_cur = 0, so_n1 = 32768, so_n2 = 65536;
    bool wpend = false;
    const LAS unsigned char* wbuf = lds + W2_LDS + wave * 4096;
    int wprev = 0;
    bf16_t* wdst = nullptr; int wK = 0; float wsc = 1.f;
    const int wpar = 0;
    for (int j = 0; j < nt; ++j) {
        if (j + 2 < nt) ATT_DMA(j + 2, so_n2);
        int wops = 0;
        if ((j & 1) == wpar) {
            if (wpend) {
                if (j + 2 < nt) asm volatile("s_waitcnt vmcnt(8)" ::: "memory"); else asm volatile("s_waitcnt vmcnt(4)" ::: "memory");
                WHalf h; h.dst = wdst; h.K = wK; h.scale = wsc; w2_proc(h, wbuf); wpend = false; wops = 2; asm volatile("s_waitcnt lgkmcnt(0)" ::: "memory"); }
            if (j + 2 < nt) { WHalf h; if (w2_decode(F, wk, h)) { w2_dma(h, lds0 + W2_LDS + (unsigned)wave * 4096u); ++wk; wpend = true; wops += 4; wdst = h.dst; wK = h.K; wsc = h.scale; } }
        }
        if (j <= cq) {
            const LAS unsigned char* kb = lds + so_cur + sub * 8192 + lane * 16;
            const LAS unsigned char* vb = lds + so_cur + 16384 + lane * 16;
            f32x16 s0 = negm, s1 = negm;
            { bf16x8 kf[8];
#pragma unroll
              for (int i = 0; i < 8; ++i) kf[i] = *(const LAS bf16x8*)(kb + i * 1024);
  #pragma unroll
              for (int s = 0; s < 4; ++s) {
                s0 = __builtin_amdgcn_mfma_f32_32x32x16_bf16(kf[s], q[s], s0, 0, 0, 0);
                s1 = __builtin_amdgcn_mfma_f32_32x32x16_bf16(kf[4 + s], q[s], s1, 0, 0, 0);
              } }
            bf16x8 va[8];
#pragma unroll
            for (int i = 0; i < 8; ++i) va[i] = *(const LAS bf16x8*)(vb + i * 1024);
            int mi = max(__float_as_int(s0[0]), __float_as_int(s1[0]));
#pragma unroll
            for (int r = 1; r < 16; ++r) mi = max(mi, max(__float_as_int(s0[r]), __float_as_int(s1[r])));
            mi = max(mi, __shfl_xor(mi, 32));
            if (j == 0 || __any(mi > 0x41000000)) {
                float dl;
                if (j == 0) {
                    float mx = fmaxf(s0[0], s1[0]);
#pragma unroll
                    for (int r = 1; r < 16; ++r) mx = fmaxf(mx, fmaxf(s0[r], s1[r]));
                    dl = fmaxf(mx, __shfl_xor(mx, 32));
                } else dl = fmaxf(__int_as_float(mi), 0.f);
                const float f = exp2_(-dl);
                m += dl; l *= f;
#pragma unroll
                for (int r = 0; r < 16; ++r) { s0[r] -= dl; s1[r] -= dl; negm[r] = -m; }
                if (j != 0) {
#pragma unroll
                    for (int d = 0; d < 4; ++d)
#pragma unroll
                        for (int r = 0; r < 16; ++r) o[d][r] *= f;
                }
            }
#pragma unroll
            for (int r = 0; r < 16; ++r) { s0[r] = exp2_(s0[r]); s1[r] = exp2_(s1[r]); }
            { float a0 = s0[0] + s1[0], a1 = s0[1] + s1[1], a2 = s0[2] + s1[2], a3 = s0[3] + s1[3];
#define ATT_ACC(a, x) do { a += (x); asm("" : "+v"(a)); } while (0)
#pragma unroll
              for (int r = 4; r < 16; r += 4) { ATT_ACC(a0, s0[r]); ATT_ACC(a1, s0[r + 1]); ATT_ACC(a2, s0[r + 2]); ATT_ACC(a3, s0[r + 3]); ATT_ACC(a0, s1[r]); ATT_ACC(a1, s1[r + 1]); ATT_ACC(a2, s1[r + 2]); ATT_ACC(a3, s1[r + 3]); }
#undef ATT_ACC
              l += (a0 + a1) + (a2 + a3); }
            bf16x8 pf[4];
#pragma unroll
            for (int ks = 0; ks < 4; ++ks) {
                u32x4 w;
                if (ks < 2) { const int b8 = 8 * ks; w.x = cvt_pk_bf16(s0[b8], s0[b8 + 1]); w.y = cvt_pk_bf16(s0[b8 + 2], s0[b8 + 3]); w.z = cvt_pk_bf16(s0[b8 + 4], s0[b8 + 5]); w.w = cvt_pk_bf16(s0[b8 + 6], s0[b8 + 7]); }
                else { const int b8 = 8 * (ks - 2); w.x = cvt_pk_bf16(s1[b8], s1[b8 + 1]); w.y = cvt_pk_bf16(s1[b8 + 2], s1[b8 + 3]); w.z = cvt_pk_bf16(s1[b8 + 4], s1[b8 + 5]); w.w = cvt_pk_bf16(s1[b8 + 6], s1[b8 + 7]); }
                pf[ks] = __builtin_bit_cast(bf16x8, w);
            }
            { bf16x8 vb2[8];
#pragma unroll
              for (int i = 0; i < 8; ++i) vb2[i] = *(const LAS bf16x8*)(vb + 8192 + i * 1024);
#pragma unroll
              for (int k2 = 0; k2 < 2; ++k2)
#pragma unroll
                for (int d = 0; d < 4; ++d) o[d] = __builtin_amdgcn_mfma_f32_32x32x16_bf16(va[k2 * 4 + d], pf[k2], o[d], 0, 0, 0);
  #pragma unroll
              for (int k2 = 0; k2 < 2; ++k2)
#pragma unroll
                for (int d = 0; d < 4; ++d) o[d] = __builtin_amdgcn_mfma_f32_32x32x16_bf16(vb2[k2 * 4 + d], pf[2 + k2], o[d], 0, 0, 0);
            }
        }
        { const int wall = ((j & 1) != wpar) ? wprev : wops;
          if (j + 2 < nt) { if (wall == 6) ATT_BARN(10); else if (wall == 4) ATT_BARN(8); else if (wall == 2) ATT_BARN(6); else ATT_BAR4(); } else ATT_BAR();
          wprev = wops; }
        { const int tmp = so_cur; so_cur = so_n1; so_n1 = so_n2; so_n2 = tmp; }
    }
    l += __shfl_xor(l, 32);
    const float inv = 1.f / l;
    LAS float* xo = (LAS float*)lds + (size_t)(wq * 64) * 64 + lane * 4;
    if (sub == 1) {
#pragma unroll
        for (int d = 0; d < 4; ++d)
#pragma unroll
            for (int i = 0; i < 4; ++i) *(LAS f32x4*)(xo + (d * 4 + i) * 256) = (f32x4){o[d][4 * i] * inv, o[d][4 * i + 1] * inv, o[d][4 * i + 2] * inv, o[d][4 * i + 3] * inv};
    }
    ATT_BAR();
    if (sub == 0) {
        float ss = 0.f;
#pragma unroll
        for (int d = 0; d < 4; ++d)
#pragma unroll
            for (int i = 0; i < 4; ++i) { const f32x4 x2 = *(const LAS f32x4*)(xo + (d * 4 + i) * 256);
#pragma unroll
                for (int j = 0; j < 4; ++j) { const float v = o[d][4 * i + j] * inv - lam * x2[j]; o[d][4 * i + j] = v; ss += v * v; } }
        ss += __shfl_xor(ss, 32);
        const float rn = rsqrtf(ss * (1.f / 128.f) + LN_EPS) * (1.f - LAMBDA_INIT);
        const LAS float* g = (const LAS float*)(lds + ATT_SUBG_LDS);
        const int h = bh & 3, b = bh >> 2;
        bf16_t* orow = (bf16_t*)(F.ws + WS_MIXIN) + (size_t)(b * 4096 + qb * 128 + wq * 32 + (lane & 31)) * 1024 + h * 128 + 8 * hi;
#pragma unroll
        for (int d = 0; d < 4; ++d)
#pragma unroll
            for (int i = 0; i < 4; i += 2) {
                const f32x4 ga = *(const LAS f32x4*)(g + 32 * d + 8 * i + 4 * hi), gb = *(const LAS f32x4*)(g + 32 * d + 8 * i + 8 + 4 * hi);
                unsigned ax = cvt_pk_bf16(o[d][4 * i] * rn * ga[0], o[d][4 * i + 1] * rn * ga[1]), ay = cvt_pk_bf16(o[d][4 * i + 2] * rn * ga[2], o[d][4 * i + 3] * rn * ga[3]);
                unsigned bx = cvt_pk_bf16(o[d][4 * i + 4] * rn * gb[0], o[d][4 * i + 5] * rn * gb[1]), by = cvt_pk_bf16(o[d][4 * i + 6] * rn * gb[2], o[d][4 * i + 7] * rn * gb[3]);
                { const auto r = __builtin_amdgcn_permlane32_swap(ax, bx, false, false); ax = r[0]; bx = r[1]; }
                { const auto r = __builtin_amdgcn_permlane32_swap(ay, by, false, false); ay = r[0]; by = r[1]; }
                *(u32x4*)(orow + 32 * d + 8 * i) = (u32x4){ax, ay, bx, by};
            }
    }
    ATT_BAR();
#undef ATT_DMA
#undef ATT_BAR4
#undef ATT_BARN
}

__device__ __forceinline__ void conv_tile(Frame& F, const int ct) {
    const int lane = lane_id(), wave = F.wave, tid = wave * 64 + lane;
    LAS unsigned char* lds = F.lds;
    const bf16_t* Hc = (const bf16_t*)(F.ws + WS_HC);
    const int t0 = ct * 64, s0 = t0 & 4095;
    const int cp = tid & 255, th = tid >> 8, c = 2 * cp;
    const GAS float* cw = (const GAS float*)in_ptr(F, 8);
    float w0[31], w1[31];
#pragma unroll
    for (int w = 0; w < 31; ++w) { const f32x2 ww = *(const GAS f32x2*)(cw + w * 512 + c); w0[w] = ww[0]; w1[w] = ww[1]; }
    const f32x2 bias = *(const GAS f32x2*)((const GAS float*)in_ptr(F, 9) + c);
    const f32x2 lg = *(const GAS f32x2*)((const GAS float*)in_ptr(F, 10) + c), lb = *(const GAS f32x2*)((const GAS float*)in_ptr(F, 11) + c);
    asm volatile("" ::: "memory");
    for (int row = wave; row < 94; row += NWAVES) {
        if (s0 - 30 + row >= 0) glds16(Hc + (size_t)(t0 - 30 + row) * 512 + lane * 8, (unsigned)__builtin_amdgcn_readfirstlane((int)((unsigned)(unsigned long)lds + (unsigned)row * 1024u)));
        else *(LAS u32x4*)(lds + row * 1024 + lane * 16) = (u32x4){0u, 0u, 0u, 0u};
    }
    ATT_BAR();
    LAS float* red = (LAS float*)(lds + 98304);
    LAS float* tot = red + 256;
    for (int hf = 0; hf < 2; ++hf) {
        float a0[16], a1[16];
#pragma unroll
        for (int it = 0; it < 4; ++it) {
#pragma unroll
            for (int oo = 0; oo < 4; ++oo) { a0[it * 4 + oo] = bias[0]; a1[it * 4 + oo] = bias[1]; }
            const LAS unsigned char* base = lds + (th * 32 + hf * 16 + it * 4) * 1024 + cp * 4;
#pragma unroll
            for (int wp = 0; wp < 34; ++wp) { const unsigned hv = *(const LAS unsigned*)(base + wp * 1024); const float x0 = bflo(hv), x1 = bfhi(hv);
#pragma unroll
                for (int oo = 0; oo < 4; ++oo) { const int w = wp - oo; if (w >= 0 && w < 31) { a0[it * 4 + oo] += x0 * w0[w]; a1[it * 4 + oo] += x1 * w1[w]; } } }
        }
        float v[32];
#pragma unroll
        for (int i = 0; i < 16; ++i) { v[2 * i] = a0[i] + a1[i]; v[2 * i + 1] = a0[i] * a0[i] + a1[i] * a1[i]; }
#pragma unroll
        for (int st = 0; st < 5; ++st) { const int half = 16 >> st, mask = 16 >> st; const bool up = (lane & mask) != 0;
#pragma unroll
            for (int i = 0; i < 16; ++i) if (i < half) { const float send = up ? v[i] : v[i + half], keep = up ? v[i + half] : v[i]; v[i] = keep + __shfl_xor(send, mask); } }
        v[0] += __shfl_xor(v[0], 32);
        if (lane < 32) red[wave * 32 + lane] = v[0];
        ATT_BAR();
        if (tid < 64) { const int hh = tid >> 5, vi = tid & 31; tot[tid] = red[(hh * 4 + 0) * 32 + vi] + red[(hh * 4 + 1) * 32 + vi] + red[(hh * 4 + 2) * 32 + vi] + red[(hh * 4 + 3) * 32 + vi]; }
        ATT_BAR();
        bf16_t* orow = (bf16_t*)(F.ws + WS_MIXIN) + (size_t)(t0 + th * 32 + hf * 16) * 1024 + 512 + c;
#pragma unroll
        for (int i = 0; i < 16; ++i) { const float mu = tot[th * 32 + 2 * i] * (1.f / 512.f), var = tot[th * 32 + 2 * i + 1] * (1.f / 512.f) - mu * mu; const float rs = rsqrtf(var + LN_EPS);
            float y0 = (a0[i] - mu) * rs * lg[0] + lb[0], y1 = (a1[i] - mu) * rs * lg[1] + lb[1]; y0 = y0 * sigmoidf_(y0); y1 = y1 * sigmoidf_(y1);
            *(unsigned*)(orow + (size_t)i * 1024) = cvt_pk_bf16(y0, y1); }
        ATT_BAR();
    }
}
#undef ATT_BAR

__device__ __forceinline__ void p2_phase(Frame& F) {
    const float lam = ((const float*)(F.ws + WS_SMALL))[0];
    { const int tid = F.wave * 64 + lane_id(); if (tid < 128) ((LAS float*)(F.lds + ATT_SUBG_LDS))[tid] = ((const GAS float*)in_ptr(F, 7))[tid];
      asm volatile("s_waitcnt vmcnt(0) lgkmcnt(0)" ::: "memory"); __builtin_amdgcn_s_barrier(); asm volatile("" ::: "memory"); }
    int wk = 0;
    for (int p = F.vcu; p < 256; p += F.G) { const int bh = p >> 4, pi = p & 15; attn_unit(F, bh, 31 - pi, lam, wk); attn_unit(F, bh, pi, lam, wk); }
    for (;;) {
        WHalf h; if (!w2_decode(F, wk, h)) break;
        w2_dma(h, (unsigned)(unsigned long)F.lds + W2_LDS + (unsigned)F.wave * 4096u); ++wk;
        asm volatile("s_waitcnt vmcnt(0)" ::: "memory");
        w2_proc(h, F.lds + W2_LDS + F.wave * 4096);
        asm volatile("s_waitcnt lgkmcnt(0)" ::: "memory");
    }
    __syncthreads();
    for (int ct = F.vcu; ct < M_TOK / 64; ct += F.G) { conv_tile(F, ct); if constexpr ((MK_DUP >> 21) & 1) conv_tile(F, ct); }
}


struct EpiP3 {
    static constexpr bool PERM = true;
    const float* x; bf16_t* Y1; float* yst;
    __device__ __forceinline__ void operator()(const f32x4 (&acc)[2][2][4][2], const pg8::Unit& u, int wr, int wc, int fr_in, int fq_in) const {
        int fr = fr_in, fq = fq_in; asm volatile("" : "+v"(fr), "+v"(fq));
#pragma unroll
        for (int ai = 0; ai < 2; ++ai)
#pragma unroll
            for (int m = 0; m < 4; ++m) {
                const size_t row = (size_t)(u.pm * 256 + ai * 128 + wr * 64 + m * 16 + fr);
                float s1 = 0.f, s2 = 0.f;
#pragma unroll
                for (int bj = 0; bj < 2; ++bj) {
                    const size_t off = row * 1024 + u.pn * 256 + bj * 128 + wc * 32 + fq * 8;
                    const u32x4 xw = *(const u32x4*)(Y1 + off);
                    const f32x4 x0 = {bflo(xw.x), bfhi(xw.x), bflo(xw.y), bfhi(xw.y)}, x1 = {bflo(xw.z), bfhi(xw.z), bflo(xw.w), bfhi(xw.w)};
                    const f32x4 y0 = x0 * ALPHA + acc[ai][bj][m][0], y1 = x1 * ALPHA + acc[ai][bj][m][1];
                    u32x4 w; w.x = cvt_pk_bf16(y0[0], y0[1]); w.y = cvt_pk_bf16(y0[2], y0[3]); w.z = cvt_pk_bf16(y1[0], y1[1]); w.w = cvt_pk_bf16(y1[2], y1[3]);
                    *(u32x4*)(Y1 + off) = w;
                    const float r0 = bflo(w.x), r1 = bfhi(w.x), r2 = bflo(w.y), r3 = bfhi(w.y), r4 = bflo(w.z), r5 = bfhi(w.z), r6 = bflo(w.w), r7 = bfhi(w.w);
                    s1 += ((r0 + r1) + (r2 + r3)) + ((r4 + r5) + (r6 + r7));
                    s2 += ((r0 * r0 + r1 * r1) + (r2 * r2 + r3 * r3)) + ((r4 * r4 + r5 * r5) + (r6 * r6 + r7 * r7));
                }
                s1 += __shfl_xor(s1, 16); s1 += __shfl_xor(s1, 32); s2 += __shfl_xor(s2, 16); s2 += __shfl_xor(s2, 32);
                if (fq == 0) *(f32x2*)(yst + (row * 16 + u.pn * 4 + wc) * 2) = (f32x2){s1, s2};
            }
    }
};

constexpr int P4_LOG = 0;
constexpr int P4_SC = 36864;
constexpr int P4_BS = 55296;
constexpr int P4_ST = 73728;
constexpr int P4_GS = 75776;
constexpr int P4_GF = 78848;
constexpr int P4_SE = 81920;
constexpr int P4_SR = 83968;
constexpr int P4_SG = 86016;
constexpr int P4_LC = 143360;
constexpr int P4_GB = 143616;
constexpr int P4_GBT = 135168;
constexpr int P4_RB = 134912;
__device__ __forceinline__ void p4_unit(Frame& F, const int ut, const bool dry) {
    const int lane = lane_id(), wave = F.wave, tid = wave * 64 + lane, rg = wave & 3, kh = wave >> 2, r = lane & 15, q = lane >> 4;
    LAS unsigned char* lds = F.lds;
    const int row0 = ut * 64, rl = rg * 16 + r, row = row0 + rl;
    const bf16_t* yrow = (const bf16_t*)(F.ws + WS_Y1) + (size_t)row * 1024 + kh * 512 + q * 8;
    const GAS float* gsrc = (const GAS float*)in_ptr(F, 13); const GAS float* bsrc = (const GAS float*)in_ptr(F, 14);
    const float gv0 = gsrc[tid], gv1 = gsrc[tid + 512], bv0 = bsrc[tid], bv1 = bsrc[tid + 512];
    const float rbv = ((const GAS float*)in_ptr(F, 16))[tid & 63];
    const f32x4* ps = (const f32x4*)((const float*)(F.ws + WS_YST) + (size_t)row * 32 + q * 8); const f32x4 sa = ps[0], sb = ps[1];
    asm volatile("" ::: "memory");
    { const bf16_t* wsrc = (const bf16_t*)(F.ws + WS_WR) + (size_t)((wave >> 1) * 16 + r) * 1024 + (wave & 1) * 512 + q * 8;
      const unsigned ldst = (unsigned)(unsigned long)lds + (unsigned)wave * 16384u;
#pragma unroll
      for (int s = 0; s < 16; ++s) glds16(wsrc + s * 32, (unsigned)__builtin_amdgcn_readfirstlane((int)(ldst + s * 1024))); }
    u32x4 ywv[16];
#pragma unroll
    for (int s = 0; s < 16; ++s) ywv[s] = *(const u32x4*)(yrow + s * 32);
    asm volatile("" ::: "memory");
    float s1 = sa[0] + sa[2] + sb[0] + sb[2], s2 = sa[1] + sa[3] + sb[1] + sb[3];
    s1 += __shfl_xor(s1, 16); s1 += __shfl_xor(s1, 32); s2 += __shfl_xor(s2, 16); s2 += __shfl_xor(s2, 32);
    if (tid < 64) ((LAS int*)(lds + P4_LC))[tid] = 0;
    const float mean = s1 * (1.f / 1024.f);
    const float var = s2 * (1.f / 1024.f) - mean * mean;
    const float rstd = rsqrtf(var + LN_EPS);
    LAS float* gl = (LAS float*)(lds + P4_GBT); LAS float* bl = gl + 1024;
    gl[tid] = gv0; gl[tid + 512] = gv1; bl[tid] = bv0; bl[tid + 512] = bv1;
    if (tid < 64) ((LAS float*)(lds + P4_RB))[tid] = rbv;
    asm volatile("s_waitcnt vmcnt(16) lgkmcnt(0)" ::: "memory"); __builtin_amdgcn_s_barrier(); asm volatile("" ::: "memory");
    const LAS float* g = gl + kh * 512 + q * 8; const LAS float* bb = bl + kh * 512 + q * 8;
    bf16_t* x1row = (bf16_t*)((dry ? F.ws + 173 * MiB : (unsigned char*)F.out) + (size_t)row * 4096) + kh * 512 + q * 8;
    const LAS unsigned char* wfr = lds + kh * 16384 + lane * 16;
    f32x4 acc[4];
#pragma unroll
    for (int gi = 0; gi < 4; ++gi) acc[gi] = (f32x4){0.f, 0.f, 0.f, 0.f};
#pragma unroll
    for (int sp = 0; sp < 8; ++sp) {
        bf16x8 wfc[2][4];
#pragma unroll
        for (int h = 0; h < 2; ++h)
#pragma unroll
            for (int gi = 0; gi < 4; ++gi) wfc[h][gi] = *(const LAS bf16x8*)(wfr + gi * 32768 + (2 * sp + h) * 1024);
#pragma unroll
        for (int h = 0; h < 2; ++h) {
            const int s = 2 * sp + h;
            const u32x4 yw = ywv[s];
            const f32x4 a = (f32x4){bflo(yw.x), bfhi(yw.x), bflo(yw.y), bfhi(yw.y)}, b = (f32x4){bflo(yw.z), bfhi(yw.z), bflo(yw.w), bfhi(yw.w)};
            const f32x4 g0 = *(const LAS f32x4*)(g + s * 32), g1 = *(const LAS f32x4*)(g + s * 32 + 4), b0 = *(const LAS f32x4*)(bb + s * 32), b1 = *(const LAS f32x4*)(bb + s * 32 + 4);
            const f32x4 xa = (a - mean) * rstd * g0 + b0, xb = (b - mean) * rstd * g1 + b1;
            u32x4 w; w.x = cvt_pk_bf16(xa[0], xa[1]); w.y = cvt_pk_bf16(xa[2], xa[3]); w.z = cvt_pk_bf16(xb[0], xb[1]); w.w = cvt_pk_bf16(xb[2], xb[3]);
            *(u32x4*)(x1row + s * 32) = w;
            const bf16x8 xf = __builtin_bit_cast(bf16x8, w);
#pragma unroll
            for (int gi = 0; gi < 4; ++gi) acc[gi] = __builtin_amdgcn_mfma_f32_16x16x32_bf16(wfc[h][gi], xf, acc[gi], 0, 0, 0);
        }
        __builtin_amdgcn_sched_barrier(0);
    }
    if constexpr ((MK_DUP >> 18) & 1) { if (dry) { asm volatile("" :: "v"(acc[0]), "v"(acc[1]), "v"(acc[2]), "v"(acc[3])); return; } }
    asm volatile("s_waitcnt lgkmcnt(0)" ::: "memory"); __builtin_amdgcn_s_barrier(); asm volatile("" ::: "memory");
    LAS float* lg = (LAS float*)(lds + P4_LOG);
#pragma unroll
    for (int gi = 0; gi < 4; ++gi) *(LAS f32x4*)(lg + (kh * 64 + rl) * 68 + gi * 16 + q * 4) = acc[gi];
    asm volatile("s_waitcnt lgkmcnt(0)" ::: "memory"); __builtin_amdgcn_s_barrier(); asm volatile("" ::: "memory");
    LAS int* lc = (LAS int*)(lds + P4_LC); LAS int* gb = (LAS int*)(lds + P4_GB);
    const int t = tid >> 3, gq = tid & 7, lbase = lane & ~7;
    float sv[8], bv[8];
    { const LAS float* rb = (const LAS float*)(lds + P4_RB); float a = -INFINITY, b2 = -INFINITY;
#pragma unroll
      for (int jx = 0; jx < 8; ++jx) { const int e = gq * 8 + jx; const float s = 1.f / (1.f + __expf(-(lg[t * 68 + e] + lg[(64 + t) * 68 + e]))); sv[jx] = s; const float v = s + rb[e]; bv[jx] = v;
          if (v > a) { b2 = a; a = v; } else if (v > b2) b2 = v; }
      const float myg = a + b2; int grank = 0;
#pragma unroll
      for (int d = 1; d < 8; ++d) { const int og = (gq + d) & 7; const float o = __shfl(myg, lbase | og); grank += (o > myg || (o == myg && og < gq)) ? 1 : 0; }
      if (grank >= 4) {
#pragma unroll
          for (int jx = 0; jx < 8; ++jx) bv[jx] = -INFINITY; } }
    int my_e = 0; float my_s = 0.f;
#pragma unroll
    for (int r = 0; r < 8; ++r) {
        float m = bv[0]; int jm = 0; float sm = sv[0];
#pragma unroll
        for (int jx = 1; jx < 8; ++jx) if (bv[jx] > m) { m = bv[jx]; jm = jx; sm = sv[jx]; }
        int e = gq * 8 + jm;
#pragma unroll
        for (int k = 1; k < 8; k <<= 1) { const float om = __shfl_xor(m, k), os = __shfl_xor(sm, k); const int oe = __shfl_xor(e, k);
            if (om > m || (om == m && oe < e)) { m = om; e = oe; sm = os; } }
        if (gq == r) { my_e = e; my_s = sm; }
        if ((e >> 3) == gq) {
#pragma unroll
            for (int jx = 0; jx < 8; ++jx) if (jx == (e & 7)) bv[jx] = -INFINITY; }
    }
    float ssum = my_s;
#pragma unroll
    for (int k = 1; k < 8; k <<= 1) ssum += __shfl_xor(ssum, k);
    const float my_gate = my_s * (ROUTED_SCALE / ssum);
    const int my_rank = __hip_atomic_fetch_add(lc + my_e, 1, __ATOMIC_RELAXED, __HIP_MEMORY_SCOPE_WORKGROUP);
    asm volatile("s_waitcnt lgkmcnt(0)" ::: "memory"); __builtin_amdgcn_s_barrier(); asm volatile("" ::: "memory");
    if constexpr ((MK_DUP >> 19) & 1) { if (dry) return; }
    if (tid < 64) gb[tid] = (int)atomicAdd(F.ctl + CW_ECNT + (dry ? 32 : 0) + 64 * tid, (unsigned)lc[tid]);
    asm volatile("s_waitcnt vmcnt(0) lgkmcnt(0)" ::: "memory"); __builtin_amdgcn_s_barrier(); asm volatile("" ::: "memory");
    { const int pos = gb[my_e] + my_rank; const int pair = (row0 + t) * 8 + gq;
      unsigned char* wsd = F.ws + (dry ? 16 * MiB : 0);
      ((int*)(wsd + WS_ROWPAIR))[(size_t)my_e * M_TOK + pos] = pair; ((float*)(wsd + WS_GATE))[pair] = my_gate; ((int*)(wsd + WS_PAIRPOS))[pair] = (my_e << 16) | pos; }
    asm volatile("s_waitcnt lgkmcnt(0)" ::: "memory"); __builtin_amdgcn_s_barrier(); asm volatile("" ::: "memory");
}
__device__ __forceinline__ void p4_phase(Frame& F, const bool dry) { for (int ut = F.vcu; ut < M_TOK / 64; ut += F.G) p4_unit(F, ut, dry); }

constexpr int MT_OFF = RING_BYTES + 1024;
struct MoeTab { volatile LAS int* cnt; volatile LAS int* cs; volatile LAS int* up; };
__device__ __forceinline__ MoeTab moe_tab(Frame& F) { MoeTab T; T.cnt = (volatile LAS int*)(F.lds + MT_OFF); T.cs = T.cnt + 80; T.up = T.cs + 80; return T; }
__device__ __forceinline__ void moe_build_tab(Frame& F) {
    MoeTab T = moe_tab(F);
    if (F.wave == 0) {
        const int e = lane_id();
        const int c = (int)__hip_atomic_load(F.ctl + CW_ECNT + 64 * e, __ATOMIC_RELAXED, __HIP_MEMORY_SCOPE_AGENT);
        const int tl = (c + 255) >> 8;
        int cs = c, up = tl;
#pragma unroll
        for (int o = 1; o < 64; o <<= 1) { const int a = __shfl_up(cs, o), b = __shfl_up(up, o); if (e >= o) { cs += a; up += b; } }
        T.cnt[e] = c; T.cs[e] = cs - c; T.up[e] = up - tl;
        if (e == 63) { T.cnt[64] = M_TOK; T.cs[64] = cs; T.up[64] = up; T.cs[65] = cs + M_TOK; T.up[65] = up + M_TOK / 256; }
    }
    __syncthreads();
}
template <bool DOWN> struct MoeSched {
    static constexpr int UF = DOWN ? 4 : 2;
    MoeTab T; int G, c, ntot; const char* Wr; const char* Ws; const int* rowpair;
    __device__ void init(Frame& F) { T = moe_tab(F); G = F.G; c = (int)blockIdx.x; ntot = T.up[65] * UF; rowpair = (const int*)(F.ws + WS_ROWPAIR);
        Wr = (const char*)(F.ws + (DOWN ? WS_WD : WS_WGU)); Ws = (const char*)(F.ws + (DOWN ? WS_WSD : WS_WSGU)); }
    __device__ bool next(int i, pg8::Unit& u) const {
        const long L = (long)i * G + c; if (L >= ntot) return false;
        int w = (int)L; { const int q = ntot / 8, r = ntot % 8, xcd = w % 8, off = w / 8; w = (xcd < r ? xcd * (q + 1) : r * (q + 1) + (xcd - r) * q) + off; }
        const int ln = lane_id();
        const int upl = T.up[ln], cntl = T.cnt[ln], csl = T.cs[ln];
        const unsigned long long below = __ballot(upl * UF <= w);
        int e = 63 - __builtin_clzll(below | 1ull);
        int cnt = __builtin_amdgcn_readlane(cntl, e), cse = __builtin_amdgcn_readlane(csl, e), upe = __builtin_amdgcn_readlane(upl, e);
        if (w >= T.up[64] * UF) { e = 64; cnt = M_TOK; cse = T.cs[64]; upe = T.up[64]; }
        const int nte = (cnt + 255) >> 8, rem = w - upe * UF;
        u.e = e; u.pn = rem % UF; u.pm = rem / UF;     (void)nte; u.cnt = min(256, cnt - 256 * u.pm); u.arow0 = cse + 256 * u.pm;
        const size_t wbytes = DOWN ? (size_t)1024 * 256 * 2 : (size_t)512 * 1024 * 2;
        const size_t tile = DOWN ? (size_t)u.pn * 256 * 256 * 2 : (size_t)u.pn * 256 * 1024 * 2;
        u.Bp = (e < 64 ? Wr + (size_t)e * wbytes : Ws) + tile; return true;
    }
    __device__ __forceinline__ int arow(const pg8::Unit& u, int r) const {
        if (DOWN) return u.arow0 + r;
        if (u.e == 64) return 256 * u.pm + r;
        return r < u.cnt ? (rowpair[(size_t)u.e * M_TOK + 256 * u.pm + r] >> 3) : 0;
    }
};
__device__ __forceinline__ float siluf_(float x) { return x * __builtin_amdgcn_rcpf(1.f + __expf(-x)); }
struct EpiP6 {
    static constexpr bool PERM = true;
    bf16_t* H; int dry;
    __device__ __forceinline__ void operator()(const f32x4 (&acc)[2][2][4][2], const pg8::Unit& u, int wr, int wc, int fr_in, int fq_in) const {
        int fr = fr_in, fq = fq_in; asm volatile("" : "+v"(fr), "+v"(fq));
if (dry) { _Pragma("unroll") for (int ai = 0; ai < 2; ++ai) _Pragma("unroll") for (int bj = 0; bj < 2; ++bj) _Pragma("unroll") for (int m = 0; m < 4; ++m) asm volatile("" :: "v"(acc[ai][bj][m][0]), "v"(acc[ai][bj][m][1])); return; }
#pragma unroll
        for (int ai = 0; ai < 2; ++ai)
#pragma unroll
            for (int m = 0; m < 4; ++m) {
                const int row = ai * 128 + wr * 64 + m * 16 + fr;
                if (row < u.cnt) {
                    f32x4 h0, h1;
#pragma unroll
                    for (int j = 0; j < 4; ++j) { h0[j] = siluf_(acc[ai][0][m][0][j]) * acc[ai][1][m][0][j]; h1[j] = siluf_(acc[ai][0][m][1][j]) * acc[ai][1][m][1][j]; }
                    u32x4 w; w.x = cvt_pk_bf16(h0[0], h0[1]); w.y = cvt_pk_bf16(h0[2], h0[3]); w.z = cvt_pk_bf16(h1[0], h1[1]); w.w = cvt_pk_bf16(h1[2], h1[3]);
                    *(u32x4*)(H + (size_t)(u.arow0 + row) * 256 + u.pn * 128 + wc * 32 + fq * 8) = w;
                }
            }
    }
};
constexpr float Y8_INV = 1.f / 16.f, Y8_MAX = 440.f;
__device__ __forceinline__ unsigned pack_fp8x4(const f32x4 v) {
    const float a = __builtin_amdgcn_fmed3f(v[0], -Y8_MAX, Y8_MAX), b = __builtin_amdgcn_fmed3f(v[1], -Y8_MAX, Y8_MAX), c = __builtin_amdgcn_fmed3f(v[2], -Y8_MAX, Y8_MAX), d = __builtin_amdgcn_fmed3f(v[3], -Y8_MAX, Y8_MAX);
    int w = __builtin_amdgcn_cvt_pk_fp8_f32(a, b, 0, false); w = __builtin_amdgcn_cvt_pk_fp8_f32(c, d, w, true); return (unsigned)w;
}
struct EpiP7 {
    static constexpr bool PERM = true;
    unsigned char* Y8; unsigned char* SH8; int dry;
    __device__ __forceinline__ void operator()(const f32x4 (&acc)[2][2][4][2], const pg8::Unit& u, int wr, int wc, int fr_in, int fq_in) const {
        int fr = fr_in, fq = fq_in; asm volatile("" : "+v"(fr), "+v"(fq));
        if (dry) { _Pragma("unroll") for (int ai = 0; ai < 2; ++ai) _Pragma("unroll") for (int bj = 0; bj < 2; ++bj) _Pragma("unroll") for (int m = 0; m < 4; ++m) asm volatile("" :: "v"(acc[ai][bj][m][0]), "v"(acc[ai][bj][m][1])); return; }
        unsigned char* base = (u.e < 64 ? Y8 + (size_t)u.arow0 * 1024 : SH8 + (size_t)(256 * u.pm) * 1024) + u.pn * 256 + wc * 64 + fq * 16;
#pragma unroll
        for (int ai = 0; ai < 2; ++ai)
#pragma unroll
            for (int m = 0; m < 4; ++m) {
                const int row = ai * 128 + wr * 64 + m * 16 + fr;
                if (row < u.cnt) { u32x4 w; w.x = pack_fp8x4(acc[ai][0][m][0]); w.y = pack_fp8x4(acc[ai][0][m][1]); w.z = pack_fp8x4(acc[ai][1][m][0]); w.w = pack_fp8x4(acc[ai][1][m][1]);
                    *(u32x4*)(base + (size_t)row * 1024) = w; }
            }
    }
};
__device__ __forceinline__ void fp8x4_fma(float (&v)[16], const int b4, const unsigned w, const float g) {
    const f32x2 lo = __builtin_amdgcn_cvt_pk_f32_fp8((int)w, false), hi = __builtin_amdgcn_cvt_pk_f32_fp8((int)w, true);
    v[b4] += g * lo[0]; v[b4 + 1] += g * lo[1]; v[b4 + 2] += g * hi[0]; v[b4 + 3] += g * hi[1];
}
__device__ __forceinline__ void p8_combine(Frame& F, const bool dry) {
    const int gw = F.vcu * NWAVES + F.wave, NGW = F.G * NWAVES, lane = lane_id();
    const unsigned char* Y8 = (const unsigned char*)(F.ws + WS_YH); const unsigned char* SH8 = (const unsigned char*)(F.ws + WS_SH);
    const int* pairpos = (const int*)(F.ws + WS_PAIRPOS); const float* gate = (const float*)(F.ws + WS_GATE); MoeTab T = moe_tab(F);
    const int cb = 256 * (lane >> 4) + 32 * ((lane >> 2) & 3) + 8 * (lane & 3);
    LAS float* gl = (LAS float*)F.lds; LAS float* bl = gl + 1024;
    { const int tid = F.wave * 64 + lane; const GAS float* gsrc = (const GAS float*)in_ptr(F, 23); const GAS float* bsrc = (const GAS float*)in_ptr(F, 24);
      gl[tid] = gsrc[tid]; gl[tid + 512] = gsrc[tid + 512]; bl[tid] = bsrc[tid]; bl[tid + 512] = bsrc[tid + 512];
      asm volatile("s_waitcnt vmcnt(0) lgkmcnt(0)" ::: "memory"); __builtin_amdgcn_s_barrier(); asm volatile("" ::: "memory"); }
    const LAS float* g = gl + cb; const LAS float* b = bl + cb;
    int ppn = 0; float ggn = 0.f;
    u32x4 xaN, xbN, ywN[9]; float gkN[9];
#define P8_ROWS(tt, pp_, gg_) do { const unsigned char* xr_ = (const unsigned char*)F.out + (size_t)(tt) * 4096; \
        xaN = *(const u32x4*)(xr_ + cb * 2); xbN = *(const u32x4*)(xr_ + cb * 2 + 256); \
        const int crow_ = T.cs[(pp_) >> 16] + ((pp_) & 0xffff); \
        _Pragma("unroll") for (int k = 0; k < 8; ++k) { const int rk = __shfl(crow_, k); gkN[k] = __shfl((gg_) * Y8_INV, k); ywN[k] = __builtin_nontemporal_load((const u32x4*)(Y8 + (size_t)rk * 1024 + lane * 16)); } \
        ywN[8] = __builtin_nontemporal_load((const u32x4*)(SH8 + (size_t)(tt) * 1024 + lane * 16)); gkN[8] = Y8_INV; } while (0)
    if (gw < M_TOK) { const int pp0 = pairpos[(size_t)gw * 8 + (lane & 7)]; const float gg0 = gate[(size_t)gw * 8 + (lane & 7)];
        if (gw + NGW < M_TOK) { ppn = pairpos[(size_t)(gw + NGW) * 8 + (lane & 7)]; ggn = gate[(size_t)(gw + NGW) * 8 + (lane & 7)]; }
        P8_ROWS(gw, pp0, gg0); }
    for (int t = gw; t < M_TOK; t += NGW) {
        const u32x4 xa = xaN, xb = xbN; u32x4 yw[9]; float gk[9];
#pragma unroll
        for (int k = 0; k < 9; ++k) { yw[k] = ywN[k]; gk[k] = gkN[k]; }
        if (t + NGW < M_TOK) { const int pp1 = ppn; const float gg1 = ggn;
            if (t + 2 * NGW < M_TOK) { ppn = pairpos[(size_t)(t + 2 * NGW) * 8 + (lane & 7)]; ggn = gate[(size_t)(t + 2 * NGW) * 8 + (lane & 7)]; }
            P8_ROWS(t + NGW, pp1, gg1); }
        float v[16];
        v[0] = ALPHA * bflo(xa.x); v[1] = ALPHA * bfhi(xa.x); v[2] = ALPHA * bflo(xa.y); v[3] = ALPHA * bfhi(xa.y); v[4] = ALPHA * bflo(xa.z); v[5] = ALPHA * bfhi(xa.z); v[6] = ALPHA * bflo(xa.w); v[7] = ALPHA * bfhi(xa.w);
        v[8] = ALPHA * bflo(xb.x); v[9] = ALPHA * bfhi(xb.x); v[10] = ALPHA * bflo(xb.y); v[11] = ALPHA * bfhi(xb.y); v[12] = ALPHA * bflo(xb.z); v[13] = ALPHA * bfhi(xb.z); v[14] = ALPHA * bflo(xb.w); v[15] = ALPHA * bfhi(xb.w);
#pragma unroll
        for (int k = 0; k < 9; ++k) { fp8x4_fma(v, 0, yw[k].x, gk[k]); fp8x4_fma(v, 4, yw[k].y, gk[k]); fp8x4_fma(v, 8, yw[k].z, gk[k]); fp8x4_fma(v, 12, yw[k].w, gk[k]);
            if (k % 3 == 2) __builtin_amdgcn_sched_barrier(0); }
        float s = 0.f;
#pragma unroll
        for (int j = 0; j < 16; ++j) s += v[j];
        const float mean = wave_sum(s) * (1.f / 1024.f);
        float qq = 0.f;
#pragma unroll
        for (int j = 0; j < 16; ++j) { v[j] -= mean; qq += v[j] * v[j]; }
        const float rstd = rsqrtf(wave_sum(qq) * (1.f / 1024.f) + LN_EPS);
        float* od = (float*)(dry ? F.ws + 173 * MiB + (size_t)t * 4096 : (unsigned char*)F.out + (size_t)t * 4096);
#pragma unroll
        for (int c4 = 0; c4 < 4; ++c4) { const int lc = (c4 >> 1) * 128 + (c4 & 1) * 4;
            const f32x4 g4 = *(const LAS f32x4*)(g + lc), b4 = *(const LAS f32x4*)(b + lc);
            *(f32x4*)(od + cb + lc) = (f32x4){v[4 * c4], v[4 * c4 + 1], v[4 * c4 + 2], v[4 * c4 + 3]} * rstd * g4 + b4; }
    }
#undef P8_ROWS
}

struct Args { const float* in[25]; float* out; unsigned char* ws; int ph_lo, ph_hi; };
__global__ void __launch_bounds__(NTHREADS, 2) mk_fwd(Args args) {
    extern __shared__ __attribute__((aligned(16))) unsigned char lds_raw[];
    cg::grid_group grid = cg::this_grid();
    Frame F;
    F.lds = (LAS unsigned char*)lds_raw;
    F.MISC = (volatile LAS unsigned*)(F.lds + MISC_OFF);
    F.wave = __builtin_amdgcn_readfirstlane((int)threadIdx.x >> 6);
    F.G = gridDim.x; { const int bx = blockIdx.x; F.vcu = (F.G % 8 == 0) ? (bx % 8) * (F.G / 8) + bx / 8 : bx; }
    F.out = args.out; F.ws = args.ws; F.ctl = (unsigned*)(args.ws + WS_CTL);
    for (int u = F.wave * 64 + lane_id(); u < (LDS_BYTES - RING_BYTES) / 4; u += NTHREADS) ((LAS unsigned*)(F.lds + RING_BYTES))[u] = 0u;
    __syncthreads();
    if (F.wave == 0 && lane_id() == 0) {
#pragma unroll
        for (int i = 0; i < 25; ++i) { const unsigned long long p = (unsigned long long)args.in[i]; F.MISC[32 + 2 * i] = (unsigned)p; F.MISC[33 + 2 * i] = (unsigned)(p >> 32); }
    }
    __syncthreads();
    XcdBarrier bar = xcd_barrier_post(F.ctl + CW_BAR, F.MISC + 8, F.wave);
    const int lo = args.ph_lo, hi = args.ph_hi;
#define IN(k) (lo <= (k) && (k) < hi)
#define BOTH(k) (IN(k) && IN((k) + 1))
#define REP(k) for (int rep_ = 0; rep_ <= ((MK_DUP >> (k)) & 1); ++rep_)
    if (IN(0)) { REP(0) p0_prologue(F); if (BOTH(0)) { xcd_barrier(bar); if constexpr ((MK_DUP >> 17) & 1) xcd_barrier(bar); } }
    if (args.ph_lo < 0) grid.sync();
    if (IN(1)) {
        REP(1) {
        { pg8::StaticOrder S; S.init(M_TOK, 2048, D_MODEL, F.ws + WS_WIN, F.G, (int)blockIdx.x); S.skip_lo = 4; S.skip_n = 2;
          EpiP1 E{(bf16_t*)(F.ws + WS_QIMG), (bf16_t*)(F.ws + WS_KIMG), (bf16_t*)(F.ws + WS_HC), (const float*)(F.ws + WS_ROPE), 0};
          if constexpr ((MK_DUP >> 22) & 1) { EpiP1 Ed = E; Ed.dry = 1; pg8::gemm_phase<EpiP1, pg8::StaticOrder, true, false>(F.lds, F.wave, F.ws + WS_XB, D_MODEL * 2, D_MODEL, S, Ed); }
          if constexpr ((MK_DUP >> 23) & 1) { pg8::gemm_phase<EpiP1, pg8::StaticOrder, true, false>(F.lds, F.wave, F.ws + WS_XB, D_MODEL * 2, D_MODEL, S, E); }
          pg8::gemm_phase<EpiP1, pg8::StaticOrder, true, false>(F.lds, F.wave, F.ws + WS_XB, D_MODEL * 2, D_MODEL, S, E); }
        { pg8::StaticOrder S; S.init(M_TOK, 512, D_MODEL, F.ws + WS_WIN, F.G, (int)((blockIdx.x + 128) % gridDim.x)); S.skip_lo = 0; S.skip_n = 4;
          EpiP1V E{(bf16_t*)(F.ws + WS_VIMG)};
          pg8::gemm_phase<EpiP1V, pg8::StaticOrder, true, true>(F.lds, F.wave, F.ws + WS_XB, D_MODEL * 2, D_MODEL, S, E); }
        if (F.G == 256 && blockIdx.x < 128)
            p0_transpose_range(F, P0_NITEMS - P0_TAIL_ITEMS, P0_NITEMS, (int)blockIdx.x * NWAVES + F.wave, 128 * NWAVES);
        }
        if (BOTH(1)) { xcd_barrier(bar); if constexpr ((MK_DUP >> 17) & 1) xcd_barrier(bar); }
    }
    if (IN(2)) { REP(2) p2_phase(F); if (BOTH(2)) { xcd_barrier(bar); if constexpr ((MK_DUP >> 17) & 1) xcd_barrier(bar); } }
    if (IN(3)) {
        pg8::StaticOrder S; S.init(M_TOK, D_MODEL, D_MODEL, F.ws + WS_WOUT, F.G, (int)blockIdx.x);
        EpiP3 E{in_ptr(F, 0), (bf16_t*)(F.ws + WS_Y1), (float*)(F.ws + WS_YST)};
        REP(3) pg8::gemm_phase<EpiP3, pg8::StaticOrder, true, false>(F.lds, F.wave, F.ws + WS_MIXIN, D_MODEL * 2, D_MODEL, S, E);
        if (BOTH(3)) { xcd_barrier(bar); if constexpr ((MK_DUP >> 17) & 1) xcd_barrier(bar); }
    }
    if (IN(4)) { if constexpr ((MK_DUP >> 4) & 1) p4_phase(F, true); p4_phase(F, false); if (BOTH(4)) { xcd_barrier(bar); if constexpr ((MK_DUP >> 17) & 1) xcd_barrier(bar); } }
    if (IN(5)) {
        moe_build_tab(F);
        MoeSched<false> S; S.init(F); EpiP6 E{(bf16_t*)(F.ws + WS_H), 0};
        if constexpr ((MK_DUP >> 24) & 1) { EpiP6 Ed = E; Ed.dry = 1; pg8::gemm_phase<EpiP6, MoeSched<false>, true, false>(F.lds, F.wave, F.out, 4096, D_MODEL, S, Ed); }
        REP(5) pg8::gemm_phase<EpiP6, MoeSched<false>, true, false>(F.lds, F.wave, F.out, 4096, D_MODEL, S, E);
        if (BOTH(5)) { xcd_barrier(bar); if constexpr ((MK_DUP >> 17) & 1) xcd_barrier(bar); }
    }
    if (IN(6)) {
        if (!IN(5)) moe_build_tab(F);
        MoeSched<true> S; S.init(F); EpiP7 E{(unsigned char*)(F.ws + WS_YH), (unsigned char*)(F.ws + WS_SH), 0};
        if constexpr ((MK_DUP >> 20) & 1) { EpiP7 Ed{(unsigned char*)(F.ws + WS_YH), (unsigned char*)(F.ws + WS_SH), 1}; pg8::gemm_phase<EpiP7, MoeSched<true>, true, false>(F.lds, F.wave, F.ws + WS_H, 512, D_EXP, S, Ed); }
        REP(6) pg8::gemm_phase<EpiP7, MoeSched<true>, true, false>(F.lds, F.wave, F.ws + WS_H, 512, D_EXP, S, E);
        if (BOTH(6)) { xcd_barrier(bar); if constexpr ((MK_DUP >> 17) & 1) xcd_barrier(bar); }
    }
    if (IN(7)) { if (!IN(5) && !IN(6)) moe_build_tab(F); if constexpr ((MK_DUP >> 7) & 1) p8_combine(F, true); p8_combine(F, false); }
#ifdef MK_PHASES_EXTRA
    MK_PHASES_EXTRA
#endif
#undef IN
#undef BOTH
}

static int mk_grid(const void* fn) {
    static int grid = 0;
    if (!grid) { int dev = 0, cus = 0, per_cu = 0; (void)hipGetDevice(&dev); (void)hipDeviceGetAttribute(&cus, hipDeviceAttributeMultiprocessorCount, dev);
        (void)hipFuncSetAttribute(fn, hipFuncAttributeMaxDynamicSharedMemorySize, LDS_BYTES);
        (void)hipOccupancyMaxActiveBlocksPerMultiprocessor(&per_cu, fn, NTHREADS, LDS_BYTES);
        if (per_cu < 1) fprintf(stderr, "mk: occupancy query says %d blocks/CU\n", per_cu);
        grid = cus; }
    return grid;
}
static void mk_launch(void* const* d_in, void* d_out, void* d_ws, hipStream_t stream, int lo, int hi) {
    const int grid = mk_grid((const void*)mk_fwd);
    Args a; memset(&a, 0, sizeof(a));
    for (int i = 0; i < 25; ++i) a.in[i] = (const float*)d_in[i];
    a.out = (float*)d_out; a.ws = (unsigned char*)d_ws; a.ph_lo = lo; a.ph_hi = hi;
    void* args[] = {&a};
    (void)hipMemsetAsync((char*)d_ws + WS_CTL, 0, CTL_ZERO_BYTES, stream);
    hipError_t e = hipLaunchCooperativeKernel((const void*)mk_fwd, dim3(grid), dim3(NTHREADS), args, LDS_BYTES, stream);
    if (e != hipSuccess) fprintf(stderr, "cooperative launch failed: %s (grid %d)\n", hipGetErrorString(e), grid);
}
extern "C" void kernel_launch(void* const* d_in, const int* in_sizes, int n_in, void* d_out, int out_size, void* d_ws, size_t ws_size, hipStream_t stream) {
    if (ws_size < WS_END || n_in != 25 || out_size != M_TOK * D_MODEL) { fprintf(stderr, "kernel_launch: unexpected sizes (ws %zu, n_in %d, out %d)\n", ws_size, n_in, out_size); return; }
    mk_launch(d_in, d_out, d_ws, stream, 0, 8);
}
```
